# Optimizing an MI355X kernel written in HIP

```python
import math
import jax, jax.numpy as jnp
from jax import lax
import numpy as np

D_MODEL = 1024
BATCH = 4
SEQ = 4096
DEPTH = 1
DEC_BATCH = 16
DEC_SEQ = 2048
PAST_LEN = 128

HEAD_DIM = 64
DIFF_HEADS = 4
DIFF_QK_DIM = HEAD_DIM
DIFF_V_DIM = 2 * HEAD_DIM
GQA_HEADS = 8
GQA_KV_HEADS = 2
GQA_GROUP = GQA_HEADS // GQA_KV_HEADS
DIFF_WIDTH = DIFF_HEADS * DIFF_V_DIM
GQA_WIDTH = GQA_HEADS * HEAD_DIM
MIX_WIDTH = DIFF_WIDTH + GQA_WIDTH
COL_SIZES = (DIFF_HEADS * 2 * DIFF_QK_DIM,
             DIFF_HEADS * 2 * DIFF_QK_DIM,
             DIFF_HEADS * DIFF_V_DIM,
             GQA_HEADS * HEAD_DIM,
             GQA_KV_HEADS * HEAD_DIM,
             GQA_KV_HEADS * HEAD_DIM)
IN_COLS = sum(COL_SIZES)
SPLITS = [int(v) for v in np.cumsum(COL_SIZES)[:-1]]
ROPE_THETA = 500000.0
PARTIAL_ROPE_DIM = HEAD_DIM // 4
AXIAL_THETA = 10000.0
GRID_W = 64
Q_BLOCK = 128
N_MEM = 256
XATTN_HEADS = 4
XATTN_HEAD_DIM = D_MODEL // XATTN_HEADS
D_FF = 2816
CONV_WIDTH = 3
EPS = 1e-6

kernel_name = "hybrid_diff_gqa2d_memxattn_convffn_encoder"


def _rmsnorm(x, g):
    x32 = x.astype(jnp.float32)
    y = x32 * lax.rsqrt(jnp.mean(x32 * x32, axis=-1, keepdims=True) + EPS)
    return (y * g.astype(jnp.float32)).astype(x.dtype)


def _rope_cos_sin(pos, dim, theta):
    inv = theta ** (-jnp.arange(0, dim, 2, dtype=jnp.float32) / dim)
    ang = pos.astype(jnp.float32)[:, None] * inv[None, :]
    return jnp.cos(ang), jnp.sin(ang)


def _rotate(x, cos, sin):
    half = x.shape[-1] // 2
    x1 = x[..., :half].astype(jnp.float32)
    x2 = x[..., half:].astype(jnp.float32)
    return jnp.concatenate([x1 * cos - x2 * sin, x1 * sin + x2 * cos], axis=-1).astype(x.dtype)


def _partial_rope(x, cos, sin):
    return jnp.concatenate([_rotate(x[..., :PARTIAL_ROPE_DIM], cos, sin), x[..., PARTIAL_ROPE_DIM:]], axis=-1)


def _axial_rope(x, cos_r, sin_r, cos_c, sin_c):
    h = HEAD_DIM // 2
    return jnp.concatenate([_rotate(x[..., :h], cos_r, sin_r), _rotate(x[..., h:], cos_c, sin_c)], axis=-1)


def _sweep_query_blocks(fn, q):
    S = q.shape[-2]
    nblk = S // Q_BLOCK
    qb = jnp.moveaxis(q.reshape(q.shape[:-2] + (nblk, Q_BLOCK, q.shape[-1])), -3, 0)
    out = lax.map(fn, qb)
    out = jnp.moveaxis(out, 0, -3)
    return out.reshape(out.shape[:-3] + (S, out.shape[-1]))


def _diff_attention(q, k, v, lam):
    scale = DIFF_QK_DIM ** -0.5
    kf = k.astype(jnp.float32)

    def block(qb):
        s = jnp.einsum('bhmqd,bhmkd->bhmqk', qb.astype(jnp.float32), kf) * scale
        p = jax.nn.softmax(s, axis=-1)
        a = p[:, :, 0] - lam * p[:, :, 1]
        return jnp.einsum('bhqk,bhkd->bhqd', a.astype(v.dtype), v)

    return _sweep_query_blocks(block, q)


def _gqa_attention(q, k, v):
    scale = HEAD_DIM ** -0.5
    kf = k.astype(jnp.float32)

    def block(qb):
        s = jnp.einsum('bkgqd,bksd->bkgqs', qb.astype(jnp.float32), kf) * scale
        p = jax.nn.softmax(s, axis=-1)
        return jnp.einsum('bkgqs,bksd->bkgqd', p.astype(v.dtype), v)

    return _sweep_query_blocks(block, q)


def _encoder_layer(x, mem, rope_tabs, layer_idx, norm_mix_g, w_in, lambda_q1, lambda_k1, lambda_q2, lambda_k2,
                   diff_subln_g, gqa_q_norm_g, gqa_k_norm_g, w_out, norm_xattn_g, norm_mem_g, w_xq, w_xkv, w_xo,
                   norm_ffn_g, w_up, conv_w, conv_b, w_down):
    B, S, _ = x.shape
    cos_p, sin_p, cos_r, sin_r, cos_c, sin_c = rope_tabs

    h = _rmsnorm(x, norm_mix_g)
    proj = jnp.einsum('bsd,de->bse', h, w_in)
    dq, dk, dv, gq, gk, gv = jnp.split(proj, SPLITS, axis=-1)

    dq = _partial_rope(dq.reshape(B, S, DIFF_HEADS, 2, DIFF_QK_DIM).transpose(0, 2, 3, 1, 4), cos_p, sin_p)
    dk = _partial_rope(dk.reshape(B, S, DIFF_HEADS, 2, DIFF_QK_DIM).transpose(0, 2, 3, 1, 4), cos_p, sin_p)
    dv = dv.reshape(B, S, DIFF_HEADS, DIFF_V_DIM).transpose(0, 2, 1, 3)
    lambda_init = 0.8 - 0.6 * math.exp(-0.3 * layer_idx)
    lam = (jnp.exp(jnp.sum(lambda_q1.astype(jnp.float32) * lambda_k1.astype(jnp.float32)))
           - jnp.exp(jnp.sum(lambda_q2.astype(jnp.float32) * lambda_k2.astype(jnp.float32)))
           + lambda_init)
    d_out = _diff_attention(dq, dk, dv, lam)
    d_out = _rmsnorm(d_out, diff_subln_g) * (1.0 - lambda_init)
    d_out = d_out.transpose(0, 2, 1, 3).reshape(B, S, DIFF_WIDTH)

    gq = _rmsnorm(gq.reshape(B, S, GQA_HEADS, HEAD_DIM), gqa_q_norm_g)
    gq = gq.reshape(B, S, GQA_KV_HEADS, GQA_GROUP, HEAD_DIM).transpose(0, 2, 3, 1, 4)
    gq = _axial_rope(gq, cos_r, sin_r, cos_c, sin_c)
    gk = _rmsnorm(gk.reshape(B, S, GQA_KV_HEADS, HEAD_DIM), gqa_k_norm_g).transpose(0, 2, 1, 3)
    gk = _axial_rope(gk, cos_r, sin_r, cos_c, sin_c)
    gv = gv.reshape(B, S, GQA_KV_HEADS, HEAD_DIM).transpose(0, 2, 1, 3)
    g_out = _gqa_attention(gq, gk, gv)
    g_out = g_out.transpose(0, 3, 1, 2, 4).reshape(B, S, GQA_WIDTH)

    x = x + jnp.einsum('bse,ed->bsd', jnp.concatenate([d_out, g_out], axis=-1), w_out)

    h = _rmsnorm(x, norm_xattn_g)
    m = _rmsnorm(mem, norm_mem_g)
    n_mem = mem.shape[1]
    q = jnp.einsum('bsd,de->bse', h, w_xq).reshape(B, S, XATTN_HEADS, XATTN_HEAD_DIM)
    kv = jnp.einsum('bmd,de->bme', m, w_xkv).reshape(B, n_mem, 2, XATTN_HEADS, XATTN_HEAD_DIM)
    mk, mv = kv[:, :, 0], kv[:, :, 1]
    s = jnp.einsum('bshd,bmhd->bhsm', q.astype(jnp.float32), mk.astype(jnp.float32)) * (XATTN_HEAD_DIM ** -0.5)
    p = jax.nn.softmax(s, axis=-1)
    o = jnp.einsum('bhsm,bmhd->bshd', p.astype(mv.dtype), mv).reshape(B, S, D_MODEL)
    x = x + jnp.einsum('bsd,de->bse', o, w_xo)

    h = _rmsnorm(x, norm_ffn_g)
    u = jnp.einsum('bsd,df->bsf', h, w_up)
    up = jnp.pad(u, ((0, 0), (1, 1), (0, 0)))
    u = up[:, :-2] * conv_w[0] + up[:, 1:-1] * conv_w[1] + up[:, 2:] * conv_w[2] + conv_b
    a, b = jnp.split(u, 2, axis=-1)
    x = x + jnp.einsum('bsf,fd->bsd', jax.nn.silu(a) * b, w_down)
    return x


def _run_trunk(x, mem, norm_mix_g, w_in, lambda_q1, lambda_k1, lambda_q2, lambda_k2, diff_subln_g,
               gqa_q_norm_g, gqa_k_norm_g, w_out, norm_xattn_g, norm_mem_g, w_xq, w_xkv, w_xo,
               norm_ffn_g, w_up, conv_w, conv_b, w_down, final_norm_g):
    S = x.shape[1]
    rows = S // GRID_W
    pos = jnp.arange(S, dtype=jnp.int32)
    row_idx = jnp.repeat(jnp.arange(rows, dtype=jnp.int32), GRID_W)
    col_idx = jnp.tile(jnp.arange(GRID_W, dtype=jnp.int32), rows)
    cos_p, sin_p = _rope_cos_sin(pos, PARTIAL_ROPE_DIM, ROPE_THETA)
    cos_r, sin_r = _rope_cos_sin(row_idx, HEAD_DIM // 2, AXIAL_THETA)
    cos_c, sin_c = _rope_cos_sin(col_idx, HEAD_DIM // 2, AXIAL_THETA)
    tabs = (cos_p, sin_p, cos_r, sin_r, cos_c, sin_c)
    for l in range(DEPTH):
        x = _encoder_layer(x, mem, tabs, l, norm_mix_g[l], w_in[l], lambda_q1[l], lambda_k1[l], lambda_q2[l],
                           lambda_k2[l], diff_subln_g[l], gqa_q_norm_g[l], gqa_k_norm_g[l], w_out[l],
                           norm_xattn_g[l], norm_mem_g[l], w_xq[l], w_xkv[l], w_xo[l], norm_ffn_g[l],
                           w_up[l], conv_w[l], conv_b[l], w_down[l])
    return _rmsnorm(x, final_norm_g)


def setup_inputs(seed: int = 0) -> dict:
    key = jax.random.key(seed)
    ks = jax.random.split(key, 26)
    f32 = jnp.float32

    def nrm(k, shape, scale):
        return jax.random.normal(k, shape, f32) * scale

    def gain(k, shape):
        return 1.0 + 0.02 * jax.random.normal(k, shape, f32)

    L = DEPTH
    return {
        "x_prompt": nrm(ks[0], (BATCH, SEQ, D_MODEL), 1.0),
        "x_sample": nrm(ks[1], (DEC_BATCH, DEC_SEQ, D_MODEL), 1.0),
        "mem_prompt": nrm(ks[2], (BATCH, N_MEM, D_MODEL), 1.0),
        "mem_sample": nrm(ks[3], (DEC_BATCH, N_MEM, D_MODEL), 1.0),
        "norm_mix_g": gain(ks[4], (L, D_MODEL)),
        "w_in": nrm(ks[5], (L, D_MODEL, IN_COLS), D_MODEL ** -0.5),
        "lambda_q1": nrm(ks[6], (L, DIFF_QK_DIM), 0.1),
        "lambda_k1": nrm(ks[7], (L, DIFF_QK_DIM), 0.1),
        "lambda_q2": nrm(ks[8], (L, DIFF_QK_DIM), 0.1),
        "lambda_k2": nrm(ks[9], (L, DIFF_QK_DIM), 0.1),
        "diff_subln_g": gain(ks[10], (L, DIFF_V_DIM)),
        "gqa_q_norm_g": gain(ks[11], (L, HEAD_DIM)),
        "gqa_k_norm_g": gain(ks[12], (L, HEAD_DIM)),
        "w_out": nrm(ks[13], (L, MIX_WIDTH, D_MODEL), MIX_WIDTH ** -0.5),
        "norm_xattn_g": gain(ks[14], (L, D_MODEL)),
        "norm_mem_g": gain(ks[15], (L, D_MODEL)),
        "w_xq": nrm(ks[16], (L, D_MODEL, D_MODEL), D_MODEL ** -0.5),
        "w_xkv": nrm(ks[17], (L, D_MODEL, 2 * D_MODEL), D_MODEL ** -0.5),
        "w_xo": nrm(ks[18], (L, D_MODEL, D_MODEL), D_MODEL ** -0.5),
        "norm_ffn_g": gain(ks[19], (L, D_MODEL)),
        "w_up": nrm(ks[20], (L, D_MODEL, 2 * D_FF), D_MODEL ** -0.5),
        "conv_w": nrm(ks[21], (L, CONV_WIDTH, 2 * D_FF), 0.5),
        "conv_b": nrm(ks[22], (L, 2 * D_FF), 0.02),
        "w_down": nrm(ks[23], (L, D_FF, D_MODEL), D_FF ** -0.5),
        "final_norm_g": gain(ks[24], (D_MODEL,)),
    }


def reference(x_prompt, x_sample, mem_prompt, mem_sample, norm_mix_g, w_in, lambda_q1, lambda_k1, lambda_q2,
              lambda_k2, diff_subln_g, gqa_q_norm_g, gqa_k_norm_g, w_out, norm_xattn_g, norm_mem_g, w_xq, w_xkv,
              w_xo, norm_ffn_g, w_up, conv_w, conv_b, w_down, final_norm_g):
    y_prompt = _run_trunk(x_prompt, mem_prompt, norm_mix_g, w_in, lambda_q1, lambda_k1, lambda_q2, lambda_k2,
                          diff_subln_g, gqa_q_norm_g, gqa_k_norm_g, w_out, norm_xattn_g, norm_mem_g, w_xq, w_xkv,
                          w_xo, norm_ffn_g, w_up, conv_w, conv_b, w_down, final_norm_g)
    y_sample = _run_trunk(x_sample, mem_sample, norm_mix_g, w_in, lambda_q1, lambda_k1, lambda_q2, lambda_k2,
                          diff_subln_g, gqa_q_norm_g, gqa_k_norm_g, w_out, norm_xattn_g, norm_mem_g, w_xq, w_xkv,
                          w_xo, norm_ffn_g, w_up, conv_w, conv_b, w_down, final_norm_g)
    return (y_prompt, y_sample)
```

```cpp
#include <hip/hip_runtime.h>
#include <hip/hip_cooperative_groups.h>
#include <cstdio>
#include <cstdint>
namespace cg = cooperative_groups;

#define LAS __attribute__((address_space(3)))
typedef unsigned short bf16_t;
typedef short bf16x8 __attribute__((ext_vector_type(8)));
typedef short s16x4 __attribute__((ext_vector_type(4)));
typedef float f32x2 __attribute__((ext_vector_type(2)));
typedef float f32x4 __attribute__((ext_vector_type(4)));
typedef float f32x16 __attribute__((ext_vector_type(16)));
typedef unsigned u32x2 __attribute__((ext_vector_type(2)));
typedef unsigned u32x4 __attribute__((ext_vector_type(4)));
typedef __bf16 bf16x2_t __attribute__((ext_vector_type(2)));

constexpr int TP = 16384, TS = 32768, TT = TP + TS, DM = 1024, NPROJ = 2304, DFF = 2816, NUP = 2 * DFF, NMEM = 5120;
constexpr float EPS = 1e-6f;
constexpr float LOG2E = 1.4426950408889634f;
constexpr float QSCALE = 0.125f * LOG2E;
constexpr float XSCALE = 0.0625f * LOG2E;

constexpr size_t MiB = 1u << 20;
constexpr size_t WS_SSQ = 0;
constexpr size_t WS_RSTD0 = 576 * 1024;
constexpr size_t WS_RSTDM = 768 * 1024;
constexpr size_t WS_TABP = 800 * 1024;
constexpr size_t WS_TABA = 1056 * 1024;
constexpr size_t WS_ONES = 1200 * 1024;
constexpr size_t WS_BAR = 1536 * 1024, BAR_BYTES = 16384;
constexpr size_t WS_WIN = 2 * MiB, WS_WOUT = 7 * MiB, WS_WXQ = 9 * MiB, WS_WXKV = 11 * MiB, WS_WXO = 15 * MiB, WS_WUP = 17 * MiB, WS_WDOWN = 28 * MiB;
constexpr size_t WS_MB = 34 * MiB, WS_KV = 44 * MiB;
constexpr size_t WS_R0 = 65 * MiB, WS_R1 = 162 * MiB, WS_RQ = 258 * MiB, WS_ACT = 162 * MiB, WS_END = 474 * MiB;

__device__ const double INVP[8] = {1.0, 0.19392274474868576, 0.03760603093086393, 0.007292664737217109, 0.001414213562373095, 0.0002742481756762073, 5.318295896944988e-05, 1.031338537721246e-05};
__device__ const double INVA[16] = {1.0, 0.5623413251903491, 0.31622776601683794, 0.1778279410038923, 0.1, 0.05623413251903491, 0.03162277660168379, 0.01778279410038923, 0.01, 0.005623413251903491,
                                    0.0031622776601683794, 0.0017782794100389228, 0.001, 0.0005623413251903491, 0.00031622776601683794, 0.00017782794100389227};

__device__ __forceinline__ unsigned pk_bf16(float lo, float hi) { f32x2 v = {lo, hi}; bf16x2_t b = __builtin_convertvector(v, bf16x2_t); return __builtin_bit_cast(unsigned, b); }
__device__ __forceinline__ float xhalf_max(float v) { const auto rr = __builtin_amdgcn_permlane32_swap(__float_as_uint(v), __float_as_uint(v), false, false); return __builtin_fmaxf(__uint_as_float(rr[0]), __uint_as_float(rr[1])); }
__device__ __forceinline__ float xrow4_sum(float v) { const auto r = __builtin_amdgcn_permlane16_swap(__float_as_uint(v), __float_as_uint(v), false, false);
    const float s = __uint_as_float(r[0]) + __uint_as_float(r[1]); const auto q = __builtin_amdgcn_permlane32_swap(__float_as_uint(s), __float_as_uint(s), false, false); return __uint_as_float(q[0]) + __uint_as_float(q[1]); }
__device__ __forceinline__ float xrow4_max(float v) { const auto r = __builtin_amdgcn_permlane16_swap(__float_as_uint(v), __float_as_uint(v), false, false);
    const float s = __builtin_fmaxf(__uint_as_float(r[0]), __uint_as_float(r[1])); const auto q = __builtin_amdgcn_permlane32_swap(__float_as_uint(s), __float_as_uint(s), false, false); return __builtin_fmaxf(__uint_as_float(q[0]), __uint_as_float(q[1])); }
__device__ __forceinline__ float row_prev(float v) { return __int_as_float(__builtin_amdgcn_update_dpp(__float_as_int(v), __float_as_int(v), 0x111, 0xf, 0xf, false)); }
__device__ __forceinline__ float row_next(float v) { return __int_as_float(__builtin_amdgcn_update_dpp(__float_as_int(v), __float_as_int(v), 0x101, 0xf, 0xf, false)); }
__device__ __forceinline__ float xhalf_sum(float v) { const auto rr = __builtin_amdgcn_permlane32_swap(__float_as_uint(v), __float_as_uint(v), false, false); return __uint_as_float(rr[0]) + __uint_as_float(rr[1]); }
__device__ __forceinline__ u32x4 widen_pair(u32x2 a, u32x2 b) {
    const auto r0 = __builtin_amdgcn_permlane32_swap(a.x, b.x, false, false), r1 = __builtin_amdgcn_permlane32_swap(a.y, b.y, false, false);
    u32x4 w; w.x = r0[0]; w.y = r1[0]; w.z = r0[1]; w.w = r1[1]; return w; }
__device__ __forceinline__ float wave_sum(float v) {
#pragma unroll
    for (int o = 1; o < 64; o <<= 1) v += __shfl_xor(v, o);
    return v;
}

namespace pg8 {
constexpr int BM = 256, BK = 64, HALF = 128, HTB = HALF * BK * 2, STAGE_BYTES = 8 * HTB, NXCD = 8, WGM = 4;
__host__ __device__ __forceinline__ int lds_byte(int r, int c) { const int st = (r >> 4) * 2 + (c >> 5), rr = r & 15, cc = c & 31, ob = rr * 64 + cc * 2; return st * 1024 + (ob ^ (((ob >> 9) & 1) << 5)); }
__host__ __device__ __forceinline__ void stage_rc(int b, int& R, int& C) { const int st = b / 1024, sb = b % 1024, swz = sb ^ (((sb >> 9) & 1) << 5); R = (st >> 1) * 16 + swz / 64; C = (st & 1) * 32 + (swz % 64) / 2; }
__host__ __device__ __forceinline__ int perm32(int rho) { const int n = rho >> 4, i = rho & 15; return 8 * (i >> 2) + 4 * n + (i & 3); }

struct Unit { int pm, pn; };
struct Gemm { const bf16_t* A; const bf16_t* Bt; int K; size_t a_tstep, a_hstep; int lda = 0, ldb = 0; };

struct StaticOrder {
    int nM, nN, nwg, G, c;
    __device__ void init(int nM_, int nN_, int G_, int c_) { nM = nM_; nN = nN_; nwg = nM * nN; G = G_; c = c_; }
    __device__ bool next(int i, Unit& u) const {
        const long L = (long)i * G + c; if (L >= nwg) return false;
        int wgid = (int)L; { const int q = nwg / NXCD, r = nwg % NXCD, xcd = wgid % NXCD, off = wgid / NXCD; wgid = (xcd < r ? xcd * (q + 1) : r * (q + 1) + (xcd - r) * q) + off; }
        const int nig = WGM * nN, gid = wgid / nig, fm = gid * WGM, gsz = (nM - fm) < WGM ? (nM - fm) : WGM;
        u.pm = fm + ((wgid % nig) % gsz); u.pn = (wgid % nig) / gsz; return true;
    }
};

__device__ __forceinline__ int mem_batch(int pm) { const int t0 = pm * 256; return (t0 < TP) ? (t0 >> 12) : 4 + ((t0 - TP) >> 11); }
template <int MAP> __device__ __forceinline__ size_t a_unit_off(const Gemm& g, const Unit& u) { if (MAP == 0) return (size_t)u.pm * g.a_tstep;
    return (size_t)(unsigned)__builtin_amdgcn_readfirstlane((int)(((unsigned)u.pm * 256u * 1024u + (unsigned)u.pn * 256u) * 2u)); }
template <int MAP> __device__ __forceinline__ size_t b_unit_off(const Gemm& g, const Unit& u, size_t tstepB) {
    if (MAP == 0) return (size_t)u.pn * tstepB;
    const unsigned mb = (unsigned)mem_batch(u.pm);
    return (size_t)(unsigned)__builtin_amdgcn_readfirstlane((int)(MAP == 1 ? (mb * 256u * 1024u + (unsigned)u.pn * 256u) * 2u : ((unsigned)u.pn * 256u * (unsigned)NMEM + mb * 256u) * 2u)); }

template <class Epi, bool CONV, int MAP = 0>
__device__ __forceinline__ void gemm_phase(LAS unsigned char* lds, const Gemm g, const StaticOrder& S, const Epi& E) {
    int tid = threadIdx.x; asm volatile("" : "+v"(tid));
    const int wid = __builtin_amdgcn_readfirstlane(tid >> 6), lane = tid & 63, wr = wid >> 2, wc = wid & 3, fr = lane & 15, fq = lane >> 4;
    const int K = g.K, nt = K / BK, lda = g.lda ? g.lda : K, ldb = g.ldb ? g.ldb : K;
    unsigned voffA[2], voffB[2];
#pragma unroll
    for (int i = 0; i < 2; ++i) { int R, C; stage_rc(tid * 16 + i * 8192, R, C); const int Rb = Epi::PERM ? ((R & ~31) + perm32(R & 31)) : R;
        const int Ra = CONV ? (126 * (R >> 6) + 8 * (R & 15) + ((R >> 4) & 3)) : R;
        voffA[i] = (unsigned)(Ra * lda + C) * 2u; voffB[i] = (unsigned)(Rb * ldb + C) * 2u; }
    const size_t kstep = (size_t)(BK * 2);
    const size_t hstepB = (size_t)HALF * ldb * 2, tstepB = 2 * hstepB;
    const size_t hstepA = g.a_hstep;
    const unsigned ldsw = (unsigned)wid * 1024u;
    const int aoff = lds_byte(wr * 64 + fr, fq * 8), boff = lds_byte(wc * 32 + fr, fq * 8);
#define PG8_SA(b, h) (((b) * 2 + (h)) * HTB)
#define PG8_SB(b, h) ((4 + (b) * 2 + (h)) * HTB)
#define PG8_STAGE(bufoff, gbase, voff) do { _Pragma("unroll") for (int _i = 0; _i < 2; ++_i) \
        __builtin_amdgcn_global_load_lds((const unsigned*)((const char*)(gbase) + (voff)[_i]), (LAS unsigned*)(lds + (bufoff) + ldsw + _i * 8192), 16, 0, 0); } while (0)
#define PG8_LDA(dst, b, h) do { _Pragma("unroll") for (int m = 0; m < 4; ++m) _Pragma("unroll") for (int k = 0; k < 2; ++k) dst[m][k] = *(const LAS bf16x8*)(lds + PG8_SA(b, h) + aoff + m * 2048 + k * 1024); } while (0)
#define PG8_LDB(dst, b, h) do { _Pragma("unroll") for (int n = 0; n < 2; ++n) _Pragma("unroll") for (int k = 0; k < 2; ++k) dst[n][k] = *(const LAS bf16x8*)(lds + PG8_SB(b, h) + boff + n * 2048 + k * 1024); } while (0)
#define PG8_MMA(ai, bj, At, Bt) do { __builtin_amdgcn_s_setprio(1); _Pragma("unroll") for (int m = 0; m < 4; ++m) _Pragma("unroll") for (int n = 0; n < 2; ++n) _Pragma("unroll") for (int k = 0; k < 2; ++k) \
        acc[ai][bj][m][n] = __builtin_amdgcn_mfma_f32_16x16x32_bf16(Bt[n][k], At[m][k], acc[ai][bj][m][n], 0, 0, 0); __builtin_amdgcn_s_setprio(0); } while (0)
#define PG8_WAIT_V(n) asm volatile("s_waitcnt vmcnt(" #n ")" ::: "memory")
#define PG8_WAIT_L(n) asm volatile("s_waitcnt lgkmcnt(" #n ")" ::: "memory")
#define PG8_BAR __builtin_amdgcn_s_barrier()
#define PG8_SCHED __builtin_amdgcn_sched_barrier(0)
    Unit cur, nxt; int ui = 0;
    if (!S.next(0, cur)) return;
    f32x4 acc[2][2][4][2];
#pragma unroll
    for (int a = 0; a < 2; ++a)
#pragma unroll
        for (int b = 0; b < 2; ++b)
#pragma unroll
            for (int m = 0; m < 4; ++m)
#pragma unroll
                for (int n = 0; n < 2; ++n) acc[a][b][m][n] = (f32x4){0.f, 0.f, 0.f, 0.f};
    bf16x8 At[4][2], B0[2][2], B1[2][2];
    const char* cA = (const char*)g.A + a_unit_off<MAP>(g, cur); const char* cB = (const char*)g.Bt + b_unit_off<MAP>(g, cur, tstepB);
    PG8_STAGE(PG8_SB(0, 0), cB, voffB); PG8_STAGE(PG8_SB(0, 1), cB + hstepB, voffB); PG8_STAGE(PG8_SA(0, 0), cA, voffA); PG8_STAGE(PG8_SA(0, 1), cA + hstepA, voffA);
    if (wr == 1) PG8_BAR;
    PG8_WAIT_V(2); PG8_BAR;
    PG8_STAGE(PG8_SB(1, 0), cB + kstep, voffB); PG8_STAGE(PG8_SA(1, 0), cA + kstep, voffA); PG8_STAGE(PG8_SB(1, 1), cB + hstepB + kstep, voffB);
    PG8_WAIT_V(6); PG8_BAR;
    for (;;) {
        const bool has_next = S.next(ui + 1, nxt);
        const char* nA = has_next ? (const char*)g.A + a_unit_off<MAP>(g, nxt) : cA; const char* nB = has_next ? (const char*)g.Bt + b_unit_off<MAP>(g, nxt, tstepB) : cB;
        for (int t = 0; t < nt; t += 2) {
            const bool last = (t == nt - 2);
            const char* a1 = cA + (size_t)(t + 1) * kstep;
            const char* a2 = last ? nA : cA + (size_t)(t + 2) * kstep; const char* b2 = last ? nB : cB + (size_t)(t + 2) * kstep;
            const char* a3 = a2 + kstep; const char* b3 = b2 + kstep;
            PG8_LDB(B0, 0, 0); PG8_LDB(B1, 0, 1); PG8_SCHED; PG8_LDA(At, 0, 0); PG8_STAGE(PG8_SA(1, 1), a1 + hstepA, voffA);
            PG8_WAIT_V(8); PG8_WAIT_L(0); PG8_BAR; PG8_MMA(0, 0, At, B0); PG8_MMA(0, 1, At, B1); PG8_BAR; PG8_SCHED;
            PG8_LDA(At, 0, 1); PG8_STAGE(PG8_SB(0, 0), b2, voffB); PG8_STAGE(PG8_SB(0, 1), b2 + hstepB, voffB); PG8_STAGE(PG8_SA(0, 0), a2, voffA);
            PG8_WAIT_V(8); PG8_WAIT_L(0); PG8_BAR; PG8_MMA(1, 0, At, B0); PG8_MMA(1, 1, At, B1); PG8_BAR; PG8_SCHED;
            PG8_LDB(B0, 1, 0); PG8_LDB(B1, 1, 1); PG8_SCHED; PG8_LDA(At, 1, 0); PG8_STAGE(PG8_SA(0, 1), a2 + hstepA, voffA);
            PG8_WAIT_V(8); PG8_WAIT_L(0); PG8_BAR; PG8_MMA(0, 0, At, B0); PG8_MMA(0, 1, At, B1); PG8_BAR; PG8_SCHED;
            PG8_LDA(At, 1, 1); PG8_STAGE(PG8_SB(1, 0), b3, voffB); PG8_STAGE(PG8_SB(1, 1), b3 + hstepB, voffB); PG8_STAGE(PG8_SA(1, 0), a3, voffA);
            PG8_WAIT_V(8); PG8_WAIT_L(0); PG8_BAR; PG8_MMA(1, 0, At, B0); PG8_MMA(1, 1, At, B1); PG8_BAR; PG8_SCHED;
        }
        if (wr == 0) PG8_BAR;
        E(acc, cur, wr, wc, fr, fq);
        if (!has_next) break;
#pragma unroll
        for (int a = 0; a < 2; ++a)
#pragma unroll
            for (int b = 0; b < 2; ++b)
#pragma unroll
                for (int m = 0; m < 4; ++m)
#pragma unroll
                    for (int n = 0; n < 2; ++n) acc[a][b][m][n] = (f32x4){0.f, 0.f, 0.f, 0.f};
        cur = nxt; cA = nA; cB = nB; ++ui;
        if (wr == 1) PG8_BAR;
    }
    PG8_WAIT_V(0);
    PG8_BAR;
#undef PG8_SA
#undef PG8_SB
#undef PG8_STAGE
#undef PG8_LDA
#undef PG8_LDB
#undef PG8_MMA
#undef PG8_WAIT_V
#undef PG8_WAIT_L
#undef PG8_BAR
#undef PG8_SCHED
}

typedef const f32x4 (&AccRef)[2][2][4][2];

constexpr float RVP[8] = {1.591549431e-01f, 3.086376340e-02f, 5.985185713e-03f, 1.160663641e-03f, 2.250790790e-04f, 4.364795279e-05f, 8.464330808e-06f, 1.641426263e-06f};
constexpr float RVA[16] = {1.591549431e-01f, 8.949940161e-02f, 5.032921210e-02f, 2.830219583e-02f, 1.591549431e-02f, 8.949940161e-03f, 5.032921210e-03f, 2.830219583e-03f,
                           1.591549431e-03f, 8.949940161e-04f, 5.032921210e-04f, 2.830219583e-04f, 1.591549431e-04f, 8.949940161e-05f, 5.032921210e-05f, 2.830219583e-05f};
struct EpiInProj {
    static constexpr bool PERM = true;
    bf16_t* QKV; const float* rstd0; const f32x2* tabP; const f32x2* tabA; const float* gq_g; const float* gk_g;
    __device__ __forceinline__ void operator()(AccRef acc, const Unit& u, int wr, int wc, int fr_, int fq_) const {
        int fr = fr_, fq = fq_; asm volatile("" : "+v"(fr), "+v"(fq));
        const int U = u.pn * 4 + wc;
        const int type = (U < 16) ? 0 : (U < 24) ? 1 : (U < 32) ? 2 : (U < 34) ? 3 : 1;
        const float sc = (U < 8 || (U >= 24 && U < 32)) ? QSCALE : 1.0f;
        float g0[8], g1[8];
        if (type >= 2) { const float* g = (type == 2) ? gq_g : gk_g;
#pragma unroll
            for (int e = 0; e < 8; ++e) { g0[e] = g[8 * fq + e]; g1[e] = g[32 + 8 * fq + e]; } }
        float rs8[8];
#pragma unroll
        for (int i = 0; i < 8; ++i) rs8[i] = rstd0[u.pm * BM + (i >> 2) * HALF + wr * 64 + (i & 3) * 16 + fr];
#pragma unroll
        for (int ai = 0; ai < 2; ++ai)
#pragma unroll
            for (int m = 0; m < 4; ++m) {
                const int t = u.pm * BM + ai * HALF + wr * 64 + m * 16 + fr;
                const float rs = rs8[ai * 4 + m];
                const int pos = (t < TP) ? (t & 4095) : (t & 2047);
                float v0[8], v1[8];
#pragma unroll
                for (int e = 0; e < 8; ++e) { v0[e] = acc[ai][0][m][e >> 2][e & 3] * rs; v1[e] = acc[ai][1][m][e >> 2][e & 3] * rs; }
                if (type == 0) {
#pragma unroll
                    for (int e = 0; e < 8; ++e) {
                        const float pr = __shfl_xor(v0[e], 16);
                        float rv = (float)pos * RVP[e]; rv -= __builtin_floorf(rv);
                        const float csx = __builtin_amdgcn_cosf(rv), csy = __builtin_amdgcn_sinf(rv);
                        const float r0 = v0[e] * csx - pr * csy, r1 = pr * csy + v0[e] * csx;
                        v0[e] = (fq == 0) ? r0 : (fq == 1) ? r1 : v0[e];
                    }
                } else if (type >= 2) {
                    float ss = 0.f;
#pragma unroll
                    for (int e = 0; e < 8; ++e) ss += v0[e] * v0[e] + v1[e] * v1[e];
                    ss = xrow4_sum(ss);
                    const float rn = 1.0f / sqrtf(ss * (1.0f / 64.0f) + EPS);
                    const int prow = pos >> 6, pcol = pos & 63;
#pragma unroll
                    for (int e = 0; e < 8; ++e) {
                        const float a0 = v0[e] * rn * g0[e], a1 = v1[e] * rn * g1[e];
                        const float p0 = __shfl_xor(a0, 32), p1 = __shfl_xor(a1, 32);
                        const float rva = (fq & 1) ? RVA[8 + e] : RVA[e];
                        const float rr = (float)prow * rva, rc = (float)pcol * rva;
                        const float c0x = __builtin_amdgcn_cosf(rr), c0y = __builtin_amdgcn_sinf(rr), c1x = __builtin_amdgcn_cosf(rc), c1y = __builtin_amdgcn_sinf(rc);
                        v0[e] = (fq < 2) ? (a0 * c0x - p0 * c0y) : (p0 * c0y + a0 * c0x);
                        v1[e] = (fq < 2) ? (a1 * c1x - p1 * c1y) : (p1 * c1y + a1 * c1x);
                    }
                }
                bf16_t* dst = QKV + (size_t)t * NPROJ + 64 * U + 8 * fq;
                u32x4 w0, w1;
                w0.x = pk_bf16(v0[0] * sc, v0[1] * sc); w0.y = pk_bf16(v0[2] * sc, v0[3] * sc); w0.z = pk_bf16(v0[4] * sc, v0[5] * sc); w0.w = pk_bf16(v0[6] * sc, v0[7] * sc);
                w1.x = pk_bf16(v1[0] * sc, v1[1] * sc); w1.y = pk_bf16(v1[2] * sc, v1[3] * sc); w1.z = pk_bf16(v1[4] * sc, v1[5] * sc); w1.w = pk_bf16(v1[6] * sc, v1[7] * sc);
                *(u32x4*)dst = w0; *(u32x4*)(dst + 32) = w1;
            }
    }
};

template <bool FROM_SSQ> struct EpiScaleBf16 {
    static constexpr bool PERM = true;
    bf16_t* O; int ldc; const float* rs; float sc;
    __device__ __forceinline__ void operator()(AccRef acc, const Unit& u, int wr, int wc, int fr_, int fq_) const {
        int fr = fr_, fq = fq_; asm volatile("" : "+v"(fr), "+v"(fq));
        const int col0 = u.pn * BM + wc * 32 + 8 * fq;
        float s8[8];
#pragma unroll
        for (int i = 0; i < 8; ++i) s8[i] = rs[u.pm * BM + (i >> 2) * HALF + wr * 64 + (i & 3) * 16 + fr];
#pragma unroll
        for (int ai = 0; ai < 2; ++ai)
#pragma unroll
            for (int m = 0; m < 4; ++m) {
                const int row = u.pm * BM + ai * HALF + wr * 64 + m * 16 + fr;
                float s = s8[ai * 4 + m]; if (FROM_SSQ) s = 1.0f / sqrtf(s * (1.0f / 1024.0f) + EPS); s *= sc;
                bf16_t* rowp = O + (size_t)row * ldc + col0;
#pragma unroll
                for (int bj = 0; bj < 2; ++bj) { const f32x4 a0 = acc[ai][bj][m][0] * s, a1 = acc[ai][bj][m][1] * s;
                    u32x4 w; w.x = pk_bf16(a0[0], a0[1]); w.y = pk_bf16(a0[2], a0[3]); w.z = pk_bf16(a1[0], a1[1]); w.w = pk_bf16(a1[2], a1[3]);
                    *(u32x4*)(rowp + bj * HALF) = w; }
            }
    }
};

struct EpiColScaleBf16 {
    static constexpr bool PERM = true;
    bf16_t* O; int ldc; const float* cs;
    __device__ __forceinline__ void operator()(AccRef acc, const Unit& u, int wr, int wc, int fr_, int fq_) const {
        int fr = fr_, fq = fq_; asm volatile("" : "+v"(fr), "+v"(fq));
        const int col0 = u.pn * BM + wc * 32 + 8 * fq;
        f32x4 c0[2], c1[2];
#pragma unroll
        for (int bj = 0; bj < 2; ++bj) { c0[bj] = *(const f32x4*)(cs + col0 + bj * HALF); c1[bj] = *(const f32x4*)(cs + col0 + bj * HALF + 4); }
#pragma unroll
        for (int ai = 0; ai < 2; ++ai)
#pragma unroll
            for (int m = 0; m < 4; ++m) {
                const int row = u.pm * BM + ai * HALF + wr * 64 + m * 16 + fr;
                bf16_t* rowp = O + (size_t)row * ldc + col0;
#pragma unroll
                for (int bj = 0; bj < 2; ++bj) { const f32x4 a0 = acc[ai][bj][m][0] * c0[bj], a1 = acc[ai][bj][m][1] * c1[bj];
                    u32x4 w; w.x = pk_bf16(a0[0], a0[1]); w.y = pk_bf16(a0[2], a0[3]); w.z = pk_bf16(a1[0], a1[1]); w.w = pk_bf16(a1[2], a1[3]);
                    *(u32x4*)(rowp + bj * HALF) = w; }
            }
    }
};
struct EpiSoftmaxP {
    static constexpr bool PERM = true;
    bf16_t* O; LAS f32x2* xch;
    __device__ __forceinline__ void operator()(f32x4 (&acc)[2][2][4][2], const Unit& u, int wr, int wc, int fr_, int fq_) const {
        int fr = fr_, fq = fq_; asm volatile("" : "+v"(fr), "+v"(fq));
        LAS f32x2* X = xch + ((u.pm + u.pn) & 1) * 1024;
#pragma unroll
        for (int ai = 0; ai < 2; ++ai)
#pragma unroll
            for (int m = 0; m < 4; ++m) {
                float mx = -INFINITY;
#pragma unroll
                for (int bj = 0; bj < 2; ++bj)
#pragma unroll
                    for (int n = 0; n < 2; ++n) { const f32x4 v = acc[ai][bj][m][n]; mx = fmaxf(mx, fmaxf(fmaxf(v[0], v[1]), fmaxf(v[2], v[3]))); }
                mx = xrow4_max(mx);
                float sm = 0.f;
#pragma unroll
                for (int bj = 0; bj < 2; ++bj)
#pragma unroll
                    for (int n = 0; n < 2; ++n) { f32x4 v = acc[ai][bj][m][n];
                        v[0] = __builtin_amdgcn_exp2f(v[0] - mx); v[1] = __builtin_amdgcn_exp2f(v[1] - mx); v[2] = __builtin_amdgcn_exp2f(v[2] - mx); v[3] = __builtin_amdgcn_exp2f(v[3] - mx);
                        sm += (v[0] + v[1]) + (v[2] + v[3]); acc[ai][bj][m][n] = v; }
                sm = xrow4_sum(sm);
                if (fq == 0) X[(ai * HALF + wr * 64 + m * 16 + fr) * 4 + wc] = (f32x2){mx, sm};
            }
        asm volatile("s_waitcnt lgkmcnt(0)" ::: "memory"); __builtin_amdgcn_s_barrier(); asm volatile("" ::: "memory");
        const int col0 = u.pn * BM + wc * 32 + 8 * fq;
#pragma unroll
        for (int ai = 0; ai < 2; ++ai)
#pragma unroll
            for (int m = 0; m < 4; ++m) {
                const int r = ai * HALF + wr * 64 + m * 16 + fr;
                const f32x2 a = X[r * 4 + 0], b = X[r * 4 + 1], c = X[r * 4 + 2], d = X[r * 4 + 3];
                const float M = fmaxf(fmaxf(a.x, b.x), fmaxf(c.x, d.x));
                const float L = (a.y * __builtin_amdgcn_exp2f(a.x - M) + b.y * __builtin_amdgcn_exp2f(b.x - M)) + (c.y * __builtin_amdgcn_exp2f(c.x - M) + d.y * __builtin_amdgcn_exp2f(d.x - M));
                const float mine = (wc == 0) ? a.x : (wc == 1) ? b.x : (wc == 2) ? c.x : d.x;
                const float f = __builtin_amdgcn_exp2f(mine - M) / L;
                bf16_t* rowp = O + (size_t)(u.pm * BM + r) * DM + col0;
#pragma unroll
                for (int bj = 0; bj < 2; ++bj) { const f32x4 a0 = acc[ai][bj][m][0] * f, a1 = acc[ai][bj][m][1] * f;
                    u32x4 w; w.x = pk_bf16(a0[0], a0[1]); w.y = pk_bf16(a0[2], a0[3]); w.z = pk_bf16(a1[0], a1[1]); w.w = pk_bf16(a1[2], a1[3]);
                    *(u32x4*)(rowp + bj * HALF) = w; }
            }
    }
};
template <int SRC> struct EpiResid {
    static constexpr bool PERM = true;
    const float* xin_p; const float* xin_s; const bf16_t* xsrc; bf16_t* xb; float* ssq;
    __device__ __forceinline__ void operator()(AccRef acc, const Unit& u, int wr, int wc, int fr, int fq) const {
        static_assert(SRC == 1, "the residual stream is bf16 everywhere");
        const int col0 = u.pn * BM + wc * 32 + 8 * fq;
        u32x4 rw[8][2];
#pragma unroll
        for (int i = 0; i < 8; ++i) { const int t = u.pm * BM + (i >> 2) * HALF + wr * 64 + (i & 3) * 16 + fr;
#pragma unroll
            for (int bj = 0; bj < 2; ++bj) rw[i][bj] = *(const u32x4*)(xsrc + (size_t)t * DM + col0 + bj * HALF); }
        __builtin_amdgcn_sched_barrier(0);
        float ssr[8];
#pragma unroll
        for (int i = 0; i < 8; ++i) {
            const int ai = i >> 2, m = i & 3, t = u.pm * BM + ai * HALF + wr * 64 + m * 16 + fr;
            float ss = 0.f;
#pragma unroll
            for (int bj = 0; bj < 2; ++bj) { const int c = col0 + bj * HALF; const u32x4 w = rw[i][bj];
                const f32x4 r0 = {__uint_as_float(w.x << 16), __uint_as_float(w.x & 0xffff0000u), __uint_as_float(w.y << 16), __uint_as_float(w.y & 0xffff0000u)};
                const f32x4 r1 = {__uint_as_float(w.z << 16), __uint_as_float(w.z & 0xffff0000u), __uint_as_float(w.w << 16), __uint_as_float(w.w & 0xffff0000u)};
                const f32x4 v0 = r0 + acc[ai][bj][m][0], v1 = r1 + acc[ai][bj][m][1];
                u32x4 o; o.x = pk_bf16(v0[0], v0[1]); o.y = pk_bf16(v0[2], v0[3]); o.z = pk_bf16(v1[0], v1[1]); o.w = pk_bf16(v1[2], v1[3]);
                *(u32x4*)(xb + (size_t)t * DM + c) = o;
                ss += ((v0[0] * v0[0] + v0[1] * v0[1]) + (v0[2] * v0[2] + v0[3] * v0[3])) + ((v1[0] * v1[0] + v1[1] * v1[1]) + (v1[2] * v1[2] + v1[3] * v1[3])); }
            ssr[i] = xrow4_sum(ss);
        }
        if (fq == 0) {
#pragma unroll
            for (int i = 0; i < 8; ++i) unsafeAtomicAdd(ssq + u.pm * BM + (i >> 2) * HALF + wr * 64 + (i & 3) * 16 + fr, ssr[i]);
        }
    }
};

struct EpiConvGate {
    static constexpr bool PERM = true;
    bf16_t* ACT; const float* ssq2; const float* conv_w; const float* conv_b;
    __device__ __forceinline__ void operator()(AccRef acc, const Unit& u, int wr, int wc, int fr_, int fq_) const {
        int fr = fr_, fq = fq_; asm volatile("" : "+v"(fr), "+v"(fq));
        const int tb = 252 * u.pm - 1 + 126 * wr + 8 * fr;
        float rs[8]; unsigned firstm = 0u, lastm = 0u, okm = 0u;
#pragma unroll
        for (int i = 0; i < 8; ++i) { const int t = tb + i; const bool valid = (t >= 0) && (t < TT);
            const int tc = valid ? t : 0; const float s = __builtin_amdgcn_rsqf(ssq2[tc] * (1.0f / 1024.0f) + EPS); rs[i] = valid ? s : 0.f;
            const int sm = (t < TP) ? 4095 : 2047;
            if ((t & sm) == 0) firstm |= 1u << i; if ((t & sm) == sm) lastm |= 1u << i;
            const bool halo = (fr == 0 && i == 0) || (fr == 15 && i == 7);
            if (valid && !halo) okm |= 1u << i; }
        const int fcol0 = 128 * u.pn + 32 * wc + 8 * fq;
#pragma unroll
        for (int n = 0; n < 2; ++n) {
            const int fc = fcol0 + 4 * n;
            const f32x4 wa0 = *(const f32x4*)(conv_w + fc), wa1 = *(const f32x4*)(conv_w + NUP + fc), wa2 = *(const f32x4*)(conv_w + 2 * NUP + fc), ba = *(const f32x4*)(conv_b + fc);
            const f32x4 wb0 = *(const f32x4*)(conv_w + DFF + fc), wb1 = *(const f32x4*)(conv_w + NUP + DFF + fc), wb2 = *(const f32x4*)(conv_w + 2 * NUP + DFF + fc), bb = *(const f32x4*)(conv_b + DFF + fc);
            float res[8][4];
#pragma unroll
            for (int j = 0; j < 4; ++j) {
                float ua[8], ub[8];
#pragma unroll
                for (int i = 0; i < 8; ++i) { ua[i] = acc[i >> 2][0][i & 3][n][j] * rs[i]; ub[i] = acc[i >> 2][1][i & 3][n][j] * rs[i]; }
                const float uap = row_prev(ua[7]), uan = row_next(ua[0]);
                const float ubp = row_prev(ub[7]), ubn = row_next(ub[0]);
#pragma unroll
                for (int i = 0; i < 8; ++i) {
                    float pa = (i == 0) ? uap : ua[i > 0 ? i - 1 : 0], na = (i == 7) ? uan : ua[i < 7 ? i + 1 : 7];
                    float pb = (i == 0) ? ubp : ub[i > 0 ? i - 1 : 0], nb = (i == 7) ? ubn : ub[i < 7 ? i + 1 : 7];
                    if (firstm & (1u << i)) { pa = 0.f; pb = 0.f; }
                    if (lastm & (1u << i)) { na = 0.f; nb = 0.f; }
                    const float ca = wa0[j] * pa + wa1[j] * ua[i] + wa2[j] * na + ba[j];
                    const float cb = wb0[j] * pb + wb1[j] * ub[i] + wb2[j] * nb + bb[j];
                    const float sg = ca * __builtin_amdgcn_rcpf(1.0f + __builtin_amdgcn_exp2f(-ca * LOG2E));
                    res[i][j] = sg * cb;
                }
            }
#pragma unroll
            for (int i = 0; i < 8; ++i) if (okm & (1u << i)) { u32x2 w; w.x = pk_bf16(res[i][0], res[i][1]); w.y = pk_bf16(res[i][2], res[i][3]);
                *(u32x2*)(ACT + (size_t)(tb + i) * DFF + fc) = w; }
        }
    }
};
}

template <int MODE> struct ACfg {
    static constexpr int DQK = (MODE == 2) ? 256 : 64;
    static constexpr int NKC = (MODE == 0) ? 8 : (MODE == 1) ? 16 : 32;
    static constexpr int DV = (MODE == 0) ? 64 : (MODE == 1) ? 128 : 256;
    static constexpr int DVW = (MODE == 0) ? 64 : 128;
    static constexpr int KBYTES = NKC * 1024, VBYTES = DV * 128, STAGE = KBYTES + VBYTES;
    static constexpr int NKI = NKC / 8, NVI = DV / 64, NS = DQK / 16, NC = DVW / 32;
    static constexpr bool PREFETCH = (MODE != 2);
};
constexpr int XCH_OFF = 65536;

template <int MODE>
__device__ __forceinline__ void attn_unit(LAS unsigned char* lds, const bf16_t* Qp, int ldq, const bf16_t* Kb, int ldk, const bf16_t* Vb, int ldv, int NT,
                                          bf16_t* Op, int ldo, float lam, const float* subg) {
    typedef ACfg<MODE> C;
    int tid = threadIdx.x; asm volatile("" : "+v"(tid));
    const int lane = tid & 63, wid = __builtin_amdgcn_readfirstlane(tid >> 6), r32 = lane & 31, hi = lane >> 5;
    const int kimg = (MODE == 1) ? (wid >> 2) : 0;
    u32x4 kreg[C::NKI], vreg[C::NVI];
    const bf16_t* kg = Kb + (size_t)lane * ldk + wid * 8;
    const bf16_t* vg = Vb + (size_t)(16 * (wid & 3) + (lane >> 2)) * ldv + 32 * (wid >> 2) + (lane & 3) * 8;
#define AT_LOADS(i) do { if ((i) < NT) { _Pragma("unroll") for (int j = 0; j < C::NKI; ++j) kreg[j] = *(const u32x4*)(kg + (size_t)(i) * 64 * ldk + 64 * j); } \
        if ((i) >= 1 && (i) <= NT) { _Pragma("unroll") for (int j = 0; j < C::NVI; ++j) vreg[j] = *(const u32x4*)(vg + (size_t)((i) - 1) * 64 * ldv + 64 * j); } } while (0)
#define AT_STORES(i) do { LAS unsigned char* sb_ = lds + ((i) & 1) * C::STAGE; if ((i) < NT) { _Pragma("unroll") for (int j = 0; j < C::NKI; ++j) *(LAS u32x4*)(sb_ + (tid + 512 * j) * 16) = kreg[j]; } \
        if ((i) >= 1 && (i) <= NT) { _Pragma("unroll") for (int j = 0; j < C::NVI; ++j) *(LAS u32x4*)(sb_ + C::KBYTES + (tid + 512 * j) * 16) = vreg[j]; } } while (0)
#define MX3(a, b, c) __builtin_fmaxf(__builtin_fmaxf((a), (b)), (c))
#define AT_ROWMAX(P0, P1, OUT) do { float a_ = MX3(P0[0], P0[1], P1[0]), b_ = MX3(P0[2], P0[3], P1[1]); a_ = MX3(a_, P1[2], P1[3]); \
        _Pragma("unroll") for (int r = 4; r < 16; r += 4) { a_ = MX3(a_, P0[r], P0[r + 1]); b_ = MX3(b_, P0[r + 2], P0[r + 3]); a_ = MX3(a_, P1[r], P1[r + 1]); b_ = MX3(b_, P1[r + 2], P1[r + 3]); } \
        OUT = xhalf_max(__builtin_fmaxf(a_, b_)); } while (0)
#define AT_QK(P0, P1, SB, CIN) do { _Pragma("unroll") for (int s = 0; s < C::NS; ++s) { \
        const bf16x8 a0_ = *(const LAS bf16x8*)((SB) + koff + s * 2048), a1_ = *(const LAS bf16x8*)((SB) + koff + s * 2048 + 512); \
        if (s == 0) { P0 = __builtin_amdgcn_mfma_f32_32x32x16_bf16(a0_, qf[0], CIN, 0, 0, 0); P1 = __builtin_amdgcn_mfma_f32_32x32x16_bf16(a1_, qf[0], CIN, 0, 0, 0); } \
        else { P0 = __builtin_amdgcn_mfma_f32_32x32x16_bf16(a0_, qf[s], P0, 0, 0, 0); P1 = __builtin_amdgcn_mfma_f32_32x32x16_bf16(a1_, qf[s], P1, 0, 0, 0); } } } while (0)
#define AT_PV1(ks, PW, SB) do { const bf16x8 pb_ = __builtin_bit_cast(bf16x8, PW); _Pragma("unroll") for (int c = 0; c < C::NC; ++c) { \
        const s16x4 lo_ = __builtin_bit_cast(s16x4, __builtin_amdgcn_ds_read_tr16_b64_v4i16((LAS s16x4*)((SB) + voff + c * 4096 + (ks) * 1024))); \
        const s16x4 h4_ = __builtin_bit_cast(s16x4, __builtin_amdgcn_ds_read_tr16_b64_v4i16((LAS s16x4*)((SB) + voff + c * 4096 + (ks) * 1024 + 512))); \
        const bf16x8 vf_ = (bf16x8){lo_[0], lo_[1], lo_[2], lo_[3], h4_[0], h4_[1], h4_[2], h4_[3]}; \
        o[c] = __builtin_amdgcn_mfma_f32_32x32x16_bf16(vf_, pb_, o[c], 0, 0, 0); } } while (0)
    const f32x16 zero16 = {0.f, 0.f, 0.f, 0.f, 0.f, 0.f, 0.f, 0.f, 0.f, 0.f, 0.f, 0.f, 0.f, 0.f, 0.f, 0.f};
    const int koff = kimg * 8192 + hi * 1024 + r32 * 16;
    const int voff = C::KBYTES + ((lane >> 4) & 1) * 32 + (lane & 3) * 8 + (4 * hi + ((lane & 15) >> 2)) * 64;
    AT_LOADS(0);
    bf16x8 qf[C::NS];
#pragma unroll
    for (int s = 0; s < C::NS; ++s) qf[s] = *(const bf16x8*)(Qp + (size_t)r32 * ldq + 16 * s + 8 * hi);
    AT_STORES(0);
    AT_LOADS(1);
    __syncthreads();
    f32x16 o[C::NC];
#pragma unroll
    for (int c = 0; c < C::NC; ++c)
#pragma unroll
        for (int r = 0; r < 16; ++r) o[c][r] = 0.f;
    f32x16 s0, s1, n0, n1;
    AT_QK(s0, s1, lds, zero16);
    AT_STORES(1);
    AT_LOADS(2);
    float m_ref, l_run = 0.f;
    AT_ROWMAX(s0, s1, m_ref);
    f32x16 negm;
#pragma unroll
    for (int r = 0; r < 16; ++r) { s0[r] -= m_ref; s1[r] -= m_ref; negm[r] = -m_ref; }
    __syncthreads();
    if (wid >= 4) __builtin_amdgcn_s_setprio(1);
#pragma clang loop unroll(disable)
    for (int t = 0; t < NT; ++t) {
        const LAS unsigned char* sb = lds + ((t + 1) & 1) * C::STAGE;
        u32x4 pw0, pw1, pw2, pw3; float ls = 0.f;
        AT_QK(n0, n1, sb, negm);
#pragma unroll
        for (int r = 0; r < 16; ++r) { s0[r] = __builtin_amdgcn_exp2f(s0[r]); s1[r] = __builtin_amdgcn_exp2f(s1[r]); ls += s0[r] + s1[r]; }
        l_run += ls;
        pw0.x = pk_bf16(s0[0], s0[1]); pw0.y = pk_bf16(s0[2], s0[3]); pw0.z = pk_bf16(s0[4], s0[5]); pw0.w = pk_bf16(s0[6], s0[7]);
        pw1.x = pk_bf16(s0[8], s0[9]); pw1.y = pk_bf16(s0[10], s0[11]); pw1.z = pk_bf16(s0[12], s0[13]); pw1.w = pk_bf16(s0[14], s0[15]);
        pw2.x = pk_bf16(s1[0], s1[1]); pw2.y = pk_bf16(s1[2], s1[3]); pw2.z = pk_bf16(s1[4], s1[5]); pw2.w = pk_bf16(s1[6], s1[7]);
        pw3.x = pk_bf16(s1[8], s1[9]); pw3.y = pk_bf16(s1[10], s1[11]); pw3.z = pk_bf16(s1[12], s1[13]); pw3.w = pk_bf16(s1[14], s1[15]);
        AT_PV1(0, pw0, sb); AT_PV1(1, pw1, sb); AT_PV1(2, pw2, sb); AT_PV1(3, pw3, sb);
        float mx; AT_ROWMAX(n0, n1, mx);
        if (t + 1 < NT && __any(mx > 8.0f)) {
            const float dl = __builtin_fmaxf(mx, 0.f), al = __builtin_amdgcn_exp2f(-dl); m_ref += dl; l_run *= al;
#pragma unroll
            for (int c = 0; c < C::NC; ++c)
#pragma unroll
                for (int r = 0; r < 16; ++r) o[c][r] *= al;
#pragma unroll
            for (int r = 0; r < 16; ++r) { n0[r] -= dl; n1[r] -= dl; negm[r] = -m_ref; }
        }
        s0 = n0; s1 = n1;
        AT_STORES(t + 2);
        AT_LOADS(t + 3);
        __syncthreads();
    }
    __builtin_amdgcn_s_setprio(0);
#undef AT_LOADS
#undef AT_STORES
#undef AT_PV1
#undef AT_QK
#undef AT_ROWMAX
#undef MX3
    l_run = xhalf_sum(l_run);
    const float inv = 1.0f / l_run;
    if (MODE == 1) {
        LAS f32x4* xch = (LAS f32x4*)(lds + XCH_OFF) + (size_t)(wid & 3) * 16 * 64 + lane;
        f32x4 ggv[C::NC][4];
        if (wid < 4) {
#pragma unroll
            for (int c = 0; c < C::NC; ++c)
#pragma unroll
                for (int g = 0; g < 4; ++g) ggv[c][g] = *(const f32x4*)(subg + 32 * c + 8 * g + 4 * hi);
        }
        __builtin_amdgcn_sched_barrier(0);
        if (wid >= 4) {
#pragma unroll
            for (int c = 0; c < C::NC; ++c)
#pragma unroll
                for (int g = 0; g < 4; ++g) xch[(c * 4 + g) * 64] = (f32x4){o[c][4 * g] * inv, o[c][4 * g + 1] * inv, o[c][4 * g + 2] * inv, o[c][4 * g + 3] * inv};
        }
        __syncthreads();
        if (wid < 4) {
            float ss = 0.f;
#pragma unroll
            for (int c = 0; c < C::NC; ++c)
#pragma unroll
                for (int g = 0; g < 4; ++g) { const f32x4 x = xch[(c * 4 + g) * 64];
#pragma unroll
                    for (int j = 0; j < 4; ++j) { const float v = o[c][4 * g + j] * inv - lam * x[j]; o[c][4 * g + j] = v; ss += v * v; } }
            ss = xhalf_sum(ss);
            const float rn = 0.8f / sqrtf(ss * (1.0f / 128.0f) + EPS);
#pragma unroll
            for (int c = 0; c < C::NC; ++c)
#pragma unroll
                for (int gp = 0; gp < 2; ++gp) { u32x2 w[2];
#pragma unroll
                    for (int q = 0; q < 2; ++q) { const int g = 2 * gp + q; const f32x4 gg = ggv[c][g];
                        w[q].x = pk_bf16(o[c][4 * g] * rn * gg[0], o[c][4 * g + 1] * rn * gg[1]); w[q].y = pk_bf16(o[c][4 * g + 2] * rn * gg[2], o[c][4 * g + 3] * rn * gg[3]); }
                    *(u32x4*)(Op + (size_t)r32 * ldo + 32 * c + 16 * gp + 8 * hi) = widen_pair(w[0], w[1]); }
        }
    } else {
#pragma unroll
        for (int c = 0; c < C::NC; ++c)
#pragma unroll
            for (int gp = 0; gp < 2; ++gp) { u32x2 w[2];
#pragma unroll
                for (int q = 0; q < 2; ++q) { const int g = 2 * gp + q;
                    w[q].x = pk_bf16(o[c][4 * g] * inv, o[c][4 * g + 1] * inv); w[q].y = pk_bf16(o[c][4 * g + 2] * inv, o[c][4 * g + 3] * inv); }
                *(u32x4*)(Op + (size_t)r32 * ldo + 32 * c + 16 * gp + 8 * hi) = widen_pair(w[0], w[1]); }
    }
}

__device__ __forceinline__ void p0_transpose_item(const float* W, int K, int N, bf16_t* WT, LAS float* scr, int item, int lane, const float* gvec, int pmode) {
    const int nblk = N / 32, kb = item / nblk, nb = item % nblk, k0 = 64 * kb, n0 = 32 * nb;
    float v[32];
#pragma unroll
    for (int i = 0; i < 32; ++i) v[i] = W[(size_t)(k0 + 2 * i + (lane >> 5)) * N + n0 + (lane & 31)];
    if (gvec) {
#pragma unroll
        for (int i = 0; i < 32; ++i) v[i] *= gvec[k0 + 2 * i + (lane >> 5)];
    }
#pragma unroll
    for (int i = 0; i < 32; ++i) scr[(2 * i + (lane >> 5)) * 33 + (lane & 31)] = v[i];
    asm volatile("s_waitcnt lgkmcnt(0)" ::: "memory");
    int r0 = n0;
    if (pmode == 1) { const int U = n0 >> 6, hf = (n0 >> 5) & 1; r0 = 256 * (U >> 2) + 128 * hf + 32 * (U & 3); }
    else if (pmode == 2) { const int hf = n0 / DFF, f = n0 - hf * DFF; r0 = 256 * (f >> 7) + 128 * hf + (f & 127); }
    const int c = lane & 7;
#pragma unroll
    for (int j = 0; j < 4; ++j) { const int n = (lane >> 3) + 8 * j; const LAS float* s = scr + (8 * c) * 33 + n;
        u32x4 o; o.x = pk_bf16(s[0 * 33], s[1 * 33]); o.y = pk_bf16(s[2 * 33], s[3 * 33]); o.z = pk_bf16(s[4 * 33], s[5 * 33]); o.w = pk_bf16(s[6 * 33], s[7 * 33]);
        *(u32x4*)(WT + (size_t)(r0 + n) * K + k0 + 8 * c) = o; }
    asm volatile("s_waitcnt lgkmcnt(0)" ::: "memory");
}
__device__ __forceinline__ void row_to_bf16(const float* xrow, bf16_t* orow, float* rstd, int lane) {
    const f32x4* xr = (const f32x4*)xrow + lane;
    f32x4 v[4]; float s = 0.f;
#pragma unroll
    for (int j = 0; j < 4; ++j) { v[j] = xr[64 * j]; s += (v[j].x * v[j].x + v[j].y * v[j].y) + (v[j].z * v[j].z + v[j].w * v[j].w); }
    s = wave_sum(s);
    if (lane == 0) *rstd = 1.0f / sqrtf(s * (1.0f / 1024.0f) + EPS);
    u32x2* o8 = (u32x2*)orow + lane;
#pragma unroll
    for (int j = 0; j < 4; ++j) { u32x2 w; w.x = pk_bf16(v[j].x, v[j].y); w.y = pk_bf16(v[j].z, v[j].w); o8[64 * j] = w; }
}

#ifndef REP0
#define REP0 1
#endif
#ifndef NSYNC_EXTRA
#define NSYNC_EXTRA 0
#endif
#ifndef PROBE_GQA2
#define PROBE_GQA2 0
#endif
#ifndef REP1
#define REP1 1
#endif
#ifndef REP2
#define REP2 1
#endif
#ifndef REP4
#define REP4 1
#endif
#ifndef REP5
#define REP5 1
#endif
#ifndef REP7
#define REP7 1
#endif

#define XB_TMO      128
#define XB_XCNT(j)  (256  + 64 * (j))
#define XB_XSUB(j)  (1280 + 64 * (j))
#define XB_XGEN(j)  (2304 + 64 * (j))
#define XB_TOP      3328
#define XB_TOPGEN   3392
#define XCD_BAR_WORDS 3456
#define XB_SPIN_CAP (1u << 22)
__device__ __forceinline__ unsigned xb_ld(unsigned* p)              { return __hip_atomic_load(p, __ATOMIC_RELAXED, __HIP_MEMORY_SCOPE_AGENT); }
__device__ __forceinline__ unsigned xb_add(unsigned* p, unsigned v) { return __hip_atomic_fetch_add(p, v, __ATOMIC_RELAXED, __HIP_MEMORY_SCOPE_AGENT); }
__device__ __forceinline__ unsigned xb_xcc_id() { return (unsigned)__builtin_amdgcn_s_getreg((3 << 11) | 20) & 0xFu; }
#define XB_SPIN(cond, bar) do { unsigned _sp = 0; while (cond) { __builtin_amdgcn_s_sleep(1); \
    if ((++_sp & 255u) == 0u) { if (xb_ld(&(bar)[XB_TMO])) break; if (_sp > XB_SPIN_CAP) { atomicAdd(&(bar)[XB_TMO], 1u); break; } } } } while (0)
struct XcdBarrier { unsigned* bar; unsigned x; volatile LAS unsigned* st; };
__device__ __forceinline__ XcdBarrier xcd_barrier_post(unsigned* bar, volatile LAS unsigned* st) {
    XcdBarrier b; b.bar = bar; b.x = xb_xcc_id(); b.st = st;
    if (threadIdx.x == 0) (void)xb_add(&bar[XB_XCNT(b.x)], 1u);
    return b;
}
__device__ __forceinline__ void xcd_barrier_complete(unsigned* bar, unsigned x, unsigned& nloc, unsigned& nx) {
    const unsigned G = gridDim.x * gridDim.y * gridDim.z;
    unsigned sum, cnt, mine, sp = 0u;
    for (;;) {
        sum = 0u; cnt = 0u; mine = 0u;
#pragma unroll
        for (unsigned j = 0; j < 16; ++j) { const unsigned c = xb_ld(&bar[XB_XCNT(j)]); sum += c; cnt += (c > 0u) ? 1u : 0u; mine = (j == x) ? c : mine; }
        if (sum == G) break;
        __builtin_amdgcn_s_sleep(1);
        if ((++sp & 255u) == 0u) { if (xb_ld(&bar[XB_TMO])) break; if (sp > XB_SPIN_CAP) { atomicAdd(&bar[XB_TMO], 1u); break; } }
    }
    nloc = mine > 0u ? mine : 1u; nx = cnt > 0u ? cnt : 1u;
}
__device__ __forceinline__ void xcd_barrier(const XcdBarrier& b) {
    asm volatile("s_waitcnt vmcnt(0)" ::: "memory");
    __syncthreads();
    if (threadIdx.x == 0) {
        unsigned* bar = b.bar;
        __builtin_amdgcn_s_waitcnt(0);
        unsigned nloc = b.st[0], nx = b.st[1];
        if (nloc == 0u) { xcd_barrier_complete(bar, b.x, nloc, nx); b.st[0] = nloc; b.st[1] = nx; }
        const unsigned old = xb_add(&bar[XB_XSUB(b.x)], 1u);
        const unsigned gen = old / nloc;
        if (old + 1u == (gen + 1u) * nloc) {
            __builtin_amdgcn_fence(__ATOMIC_RELEASE, "agent");
            asm volatile("s_waitcnt vmcnt(0)" ::: "memory");
            const unsigned og = xb_add(&bar[XB_TOP], 1u);
            const unsigned tg = og / nx;
            if (og + 1u == (tg + 1u) * nx) xb_add(&bar[XB_TOPGEN], 1u);
            else XB_SPIN(xb_ld(&bar[XB_TOPGEN]) == tg, bar);
            __builtin_amdgcn_fence(__ATOMIC_ACQUIRE, "agent");
            xb_add(&bar[XB_XGEN(b.x)], 1u);
            asm volatile("s_waitcnt vmcnt(0)" ::: "memory");
        } else {
            XB_SPIN(xb_ld(&bar[XB_XGEN(b.x)]) == gen, bar);
            __builtin_amdgcn_fence(__ATOMIC_ACQUIRE, "agent");
            asm volatile("s_waitcnt vmcnt(0)" ::: "memory");
        }
    }
    __syncthreads();
}

struct Args { const float* in[25]; float* out; unsigned char* ws; int ph_lo, ph_hi; };
constexpr int LDS_BYTES = 131072 + 1024 + 16384;

__global__ void __launch_bounds__(512, 2) fwd_mega(Args a) {
    __builtin_assume(__builtin_amdgcn_workitem_id_y() == 0); __builtin_assume(__builtin_amdgcn_workitem_id_z() == 0);
    extern __shared__ __attribute__((aligned(16))) unsigned char lds_raw[];
    LAS unsigned char* lds = (LAS unsigned char*)lds_raw;
    cg::grid_group grid = cg::this_grid();
    const int tid = threadIdx.x, lane = tid & 63, wave = __builtin_amdgcn_readfirstlane(tid >> 6);
    const int G = gridDim.x, bx = blockIdx.x;
    const int vcu = (G % 8 == 0) ? (bx % 8) * (G / 8) + bx / 8 : bx;
    unsigned char* ws = a.ws;
    float* ssq1 = (float*)(ws + WS_SSQ); float* ssq2 = ssq1 + TT; float* ssq3 = ssq2 + TT;
    float* rstd0 = (float*)(ws + WS_RSTD0); float* rstdm = (float*)(ws + WS_RSTDM); float* ones = (float*)(ws + WS_ONES);
    f32x2* tabP = (f32x2*)(ws + WS_TABP); f32x2* tabA = (f32x2*)(ws + WS_TABA);
    bf16_t* Wi = (bf16_t*)(ws + WS_WIN); bf16_t* Wo = (bf16_t*)(ws + WS_WOUT); bf16_t* Wq = (bf16_t*)(ws + WS_WXQ); bf16_t* Wkv = (bf16_t*)(ws + WS_WXKV);
    bf16_t* Wxo = (bf16_t*)(ws + WS_WXO); bf16_t* Wu = (bf16_t*)(ws + WS_WUP); bf16_t* Wd = (bf16_t*)(ws + WS_WDOWN);
    bf16_t* MB = (bf16_t*)(ws + WS_MB); bf16_t* KV = (bf16_t*)(ws + WS_KV); bf16_t* VT = (bf16_t*)(ws + WS_KV + 10 * MiB);
    bf16_t* D1 = (bf16_t*)a.out + (size_t)TT * DM;
    bf16_t* D0 = (bf16_t*)a.out;
    bf16_t* R0 = (bf16_t*)(ws + WS_R0); bf16_t* R1 = (bf16_t*)(ws + WS_R1); bf16_t* RQ = (bf16_t*)(ws + WS_RQ); bf16_t* ACT = (bf16_t*)(ws + WS_ACT);
    volatile LAS unsigned* bst = (volatile LAS unsigned*)(lds + 131072 + 64);
    if (tid < 2) bst[tid] = 0u;
    __syncthreads();
    const XcdBarrier xbar = xcd_barrier_post((unsigned*)(ws + WS_BAR), bst);
    const int lo = a.ph_lo, hi_ = a.ph_hi;
#define IN(k) (lo <= (k) && (k) < hi_)
#define SEAM(k) do { if (IN(k) && IN((k) + 1)) xcd_barrier(xbar); } while (0)

    if (IN(0)) for (int rep0 = 0; rep0 < REP0; ++rep0) {
        const int gw = vcu * 8 + wave, NGW = G * 8, gtid = bx * 512 + tid, NTH = G * 512;
        for (int i = gtid; i < 3 * TT; i += NTH) ssq1[i] = 0.f;
        for (int i = gtid; i < TT; i += NTH) ones[i] = 1.0f;
        LAS float* scr = (LAS float*)(lds + wave * 16384);
        constexpr int I_IN = 16 * 72, I_SQ = 16 * 32, I_KV = 16 * 64, I_UP = 16 * 176, I_DN = 44 * 32;
        constexpr int NITEMS = I_IN + 3 * I_SQ + I_KV + I_UP + I_DN;
        for (int it = gw; it < NITEMS; it += NGW) {
            int r = it;
            if (r < I_IN) { p0_transpose_item(a.in[5], DM, NPROJ, Wi, scr, r, lane, a.in[4], 1); continue; } r -= I_IN;
            if (r < I_SQ) { p0_transpose_item(a.in[13], DM, DM, Wo, scr, r, lane, nullptr, 0); continue; } r -= I_SQ;
            if (r < I_SQ) { p0_transpose_item(a.in[16], DM, DM, Wq, scr, r, lane, a.in[14], 0); continue; } r -= I_SQ;
            if (r < I_KV) { p0_transpose_item(a.in[17], DM, 2 * DM, Wkv, scr, r, lane, a.in[15], 0); continue; } r -= I_KV;
            if (r < I_SQ) { p0_transpose_item(a.in[18], DM, DM, Wxo, scr, r, lane, nullptr, 0); continue; } r -= I_SQ;
            if (r < I_UP) { p0_transpose_item(a.in[20], DM, NUP, Wu, scr, r, lane, a.in[19], 2); continue; } r -= I_UP;
            p0_transpose_item(a.in[23], DFF, DM, Wd, scr, r, lane, nullptr, 0);
        }
        for (int m0 = gw; m0 < TT; m0 += 4 * NGW) {
            f32x4 v[4][4]; float sq[4];
#pragma unroll
            for (int q = 0; q < 4; ++q) { const int m = m0 + q * NGW; const int mc = (m < TT) ? m : gw;
                const f32x4* xr = (const f32x4*)((mc < TP) ? a.in[0] + (size_t)mc * DM : a.in[1] + (size_t)(mc - TP) * DM) + lane;
#pragma unroll
                for (int j = 0; j < 4; ++j) v[q][j] = xr[64 * j]; }
#pragma unroll
            for (int q = 0; q < 4; ++q) { float s_ = 0.f;
#pragma unroll
                for (int j = 0; j < 4; ++j) s_ += (v[q][j].x * v[q][j].x + v[q][j].y * v[q][j].y) + (v[q][j].z * v[q][j].z + v[q][j].w * v[q][j].w);
                sq[q] = wave_sum(s_); }
#pragma unroll
            for (int q = 0; q < 4; ++q) { const int m = m0 + q * NGW; if (m < TT) {
                if (lane == 0) rstd0[m] = 1.0f / sqrtf(sq[q] * (1.0f / 1024.0f) + EPS);
                u32x2* o8 = (u32x2*)(D1 + (size_t)m * DM) + lane;
#pragma unroll
                for (int j = 0; j < 4; ++j) { u32x2 w; w.x = pk_bf16(v[q][j].x, v[q][j].y); w.y = pk_bf16(v[q][j].z, v[q][j].w); o8[64 * j] = w; } } }
        }
        for (int m = gw; m < NMEM; m += NGW) { const float* xr = (m < 1024) ? a.in[2] + (size_t)m * DM : a.in[3] + (size_t)(m - 1024) * DM; row_to_bf16(xr, MB + (size_t)m * DM, rstdm + m, lane); }
        __syncthreads();
    }
    SEAM(0);
    for (int xs = 0; xs < NSYNC_EXTRA; ++xs) grid.sync();

    if (IN(1)) for (int rep = 0; rep < REP1; ++rep) {
        { pg8::Gemm g{D1, Wi, DM, (size_t)256 * DM * 2, (size_t)128 * DM * 2}; pg8::StaticOrder S; S.init(TT / 256, NPROJ / 256, G, bx);
          pg8::EpiInProj E{RQ, rstd0, tabP, tabA, a.in[11], a.in[12]};
          pg8::gemm_phase<pg8::EpiInProj, false>(lds, g, S, E); }
        { pg8::Gemm g{MB, Wkv, DM, (size_t)256 * DM * 2, (size_t)128 * DM * 2}; pg8::StaticOrder S; S.init(NMEM / 256, DM / 256, G, (bx + 64) % G);
          pg8::EpiScaleBf16<false> E{KV, DM, rstdm, 1.0f};
          pg8::gemm_phase<pg8::EpiScaleBf16<false>, false>(lds, g, S, E); }
        { pg8::Gemm g{Wkv + (size_t)DM * DM, MB, DM, (size_t)256 * DM * 2, (size_t)128 * DM * 2}; pg8::StaticOrder S; S.init(DM / 256, NMEM / 256, G, (bx + 240) % G);
          pg8::EpiColScaleBf16 E{VT, NMEM, rstdm};
          pg8::gemm_phase<pg8::EpiColScaleBf16, false>(lds, g, S, E); }
    }
    SEAM(1);

    if (IN(2)) for (int rep = 0; rep < REP2; ++rep) {
        float lam;
        { const float s1 = wave_sum(a.in[6][lane] * a.in[7][lane]), s2 = wave_sum(a.in[8][lane] * a.in[9][lane]); lam = expf(s1) - expf(s2) + 0.2f; }
        for (int cls0 = 0; cls0 < 4 + PROBE_GQA2; ++cls0) { const int cls = (cls0 < 4) ? cls0 : cls0 - 2;
            const int n = (cls & 1) ? 1024 : 512, per = (n + G - 1) / G;
            const int i0 = vcu * per, i1 = (i0 + per < n) ? i0 + per : n;
            for (int id = i0; id < i1; ++id) {
                if (cls < 2) {
                    const int nqb = cls ? 16 : 32, S_ = cls ? 2048 : 4096;
                    const int qb = id % nqb, h = (id / nqb) & 3, seq = id / (nqb * 4);
                    const size_t row0 = (cls ? TP : 0) + (size_t)seq * S_, qrow = row0 + (size_t)qb * 128 + 32 * (wave & 3);
                    attn_unit<1>(lds, RQ + qrow * NPROJ + h * 128 + (wave >> 2) * 64, NPROJ, RQ + row0 * NPROJ + 512 + h * 128, NPROJ, RQ + row0 * NPROJ + 1024 + h * 128, NPROJ, S_ / 64,
                                 R0 + qrow * DM + h * 128, DM, lam, a.in[10]);
                } else {
                    const int nqb = (cls & 1) ? 8 : 16, S_ = (cls & 1) ? 2048 : 4096;
                    const int qb = id % nqb, h = (id / nqb) & 7, seq = id / (nqb * 8);
                    const size_t row0 = ((cls & 1) ? TP : 0) + (size_t)seq * S_, qrow = row0 + (size_t)qb * 256 + 32 * wave;
                    attn_unit<0>(lds, RQ + qrow * NPROJ + 1536 + h * 64, NPROJ, RQ + row0 * NPROJ + 2048 + (h >> 2) * 64, NPROJ, RQ + row0 * NPROJ + 2176 + (h >> 2) * 64, NPROJ, S_ / 64,
                                 R0 + qrow * DM + 512 + h * 64, DM, 0.f, nullptr);
                }
            }
        }
    }
    SEAM(2);

    if (IN(3)) {
        pg8::Gemm g{R0, Wo, DM, (size_t)256 * DM * 2, (size_t)128 * DM * 2}; pg8::StaticOrder S; S.init(TT / 256, DM / 256, G, bx);
        pg8::EpiResid<1> E{nullptr, nullptr, D1, D0, ssq1};
        pg8::gemm_phase<pg8::EpiResid<1>, false>(lds, g, S, E);
    }
    SEAM(3);

    if (IN(4)) for (int rep = 0; rep < REP4; ++rep) {
        pg8::Gemm g{D0, Wq, DM, (size_t)256 * DM * 2, (size_t)128 * DM * 2}; pg8::StaticOrder S; S.init(TT / 256, DM / 256, G, bx);
        pg8::EpiScaleBf16<true> E{R0, DM, ssq1, XSCALE};
        pg8::gemm_phase<pg8::EpiScaleBf16<true>, false>(lds, g, S, E);
    }
    SEAM(4);

    if (IN(5)) {
        { pg8::Gemm g{R0, KV, 256, 0, (size_t)128 * DM * 2, DM, DM}; pg8::StaticOrder S; S.init(TT / 256, 4, G, bx);
          pg8::EpiSoftmaxP E{R0, (LAS f32x2*)(lds + 131072 + 1024)};
          pg8::gemm_phase<pg8::EpiSoftmaxP, false, 1>(lds, g, S, E); }
        xcd_barrier(xbar);
        { pg8::Gemm g{R0, VT, 256, 0, (size_t)128 * DM * 2, DM, NMEM}; pg8::StaticOrder S; S.init(TT / 256, 4, G, bx);
          pg8::EpiScaleBf16<false> E{R1, DM, ones, 1.0f};
          pg8::gemm_phase<pg8::EpiScaleBf16<false>, false, 2>(lds, g, S, E); }
    }
    SEAM(5);

    if (IN(6)) {
        pg8::Gemm g{R1, Wxo, DM, (size_t)256 * DM * 2, (size_t)128 * DM * 2}; pg8::StaticOrder S; S.init(TT / 256, DM / 256, G, bx);
        pg8::EpiResid<1> E{nullptr, nullptr, D0, R0, ssq2};
        pg8::gemm_phase<pg8::EpiResid<1>, false>(lds, g, S, E);
    }
    SEAM(6);

    if (IN(7)) for (int rep = 0; rep < REP7; ++rep) {
        pg8::Gemm g{R0 - DM, Wu, DM, (size_t)252 * DM * 2, (size_t)4 * DM * 2}; pg8::StaticOrder S; S.init((TT + 251) / 252, DFF / 128, G, bx);
        pg8::EpiConvGate E{ACT, ssq2, a.in[21], a.in[22]};
        pg8::gemm_phase<pg8::EpiConvGate, true>(lds, g, S, E);
    }
    SEAM(7);

    if (IN(8)) {
        pg8::Gemm g{ACT, Wd, DFF, (size_t)256 * DFF * 2, (size_t)128 * DFF * 2}; pg8::StaticOrder S; S.init(TT / 256, DM / 256, G, bx);
        pg8::EpiResid<1> E{nullptr, nullptr, R0, R0, ssq3};
        pg8::gemm_phase<pg8::EpiResid<1>, false>(lds, g, S, E);
    }
    SEAM(8);

    if (IN(9)) {
        int t9 = threadIdx.x; asm volatile("" : "+v"(t9)); const int lane9 = t9 & 63;
        const int gw = vcu * 8 + wave, NGW = G * 8;
        const f32x4* gp = (const f32x4*)a.in[24] + lane9;
        f32x4 gv[4];
#pragma unroll
        for (int j = 0; j < 4; ++j) gv[j] = gp[64 * j];
        for (int m0 = gw; m0 < TT; m0 += 8 * NGW) {
            u32x2 v[8][4]; float rs[8];
#pragma unroll
            for (int q = 0; q < 8; ++q) { const int m = m0 + q * NGW; const int mc = (m < TT) ? m : gw;
                const u32x2* xr = (const u32x2*)(R0 + (size_t)mc * DM) + lane9; rs[q] = ssq3[mc];
#pragma unroll
                for (int j = 0; j < 4; ++j) v[q][j] = xr[64 * j]; }
#pragma unroll
            for (int q = 0; q < 8; ++q) { const int m = m0 + q * NGW; if (m < TT) {
                const float r_ = 1.0f / sqrtf(rs[q] * (1.0f / 1024.0f) + EPS);
                f32x4* xw = (f32x4*)(a.out + (size_t)m * DM) + lane9;
#pragma unroll
                for (int j = 0; j < 4; ++j) { const f32x4 x = {__uint_as_float(v[q][j].x << 16), __uint_as_float(v[q][j].x & 0xffff0000u), __uint_as_float(v[q][j].y << 16), __uint_as_float(v[q][j].y & 0xffff0000u)};
                    xw[64 * j] = x * r_ * gv[j]; } } }
        }
    }
    if (a.ph_hi > 1000) grid.sync();
#undef IN
#undef SEAM
}

extern "C" void kernel_launch(void* const* d_in, const int* in_sizes, int n_in, void* d_out, int out_size, void* d_ws, size_t ws_size, hipStream_t stream) {
    static int grid = 0;
    if (grid == 0) {
        if (n_in != 25 || out_size != TT * DM || ws_size < WS_END) { fprintf(stderr, "kernel_launch: unexpected shapes (n_in %d out %d ws %zu)\n", n_in, out_size, ws_size); grid = -1; return; }
        int dev = 0, cus = 0, per_cu = 0;
        hipGetDevice(&dev); hipDeviceGetAttribute(&cus, hipDeviceAttributeMultiprocessorCount, dev);
        hipFuncSetAttribute((const void*)fwd_mega, hipFuncAttributeMaxDynamicSharedMemorySize, LDS_BYTES);
        hipOccupancyMaxActiveBlocksPerMultiprocessor(&per_cu, (const void*)fwd_mega, 512, LDS_BYTES);
        if (per_cu < 1) { fprintf(stderr, "kernel_launch: occupancy query says %d blocks/CU\n", per_cu); per_cu = 1; }
        (void)hipGetLastError();
        grid = cus * per_cu;
    }
    if (grid < 0) return;
    if (hipMemsetAsync((char*)d_ws + WS_BAR, 0, BAR_BYTES, stream) != hipSuccess) { fprintf(stderr, "kernel_launch: memset of barrier words failed\n"); return; }
    Args a{};
    for (int i = 0; i < 25; ++i) a.in[i] = (const float*)d_in[i];
    a.out = (float*)d_out; a.ws = (unsigned char*)d_ws; a.ph_lo = 0; a.ph_hi = 10;
    void* args[] = {&a};
    hipError_t e = hipLaunchCooperativeKernel((const void*)fwd_mega, dim3(grid), dim3(512), args, LDS_BYTES, stream);
    if (e != hipSuccess) fprintf(stderr, "cooperative launch failed: %s (grid %d)\n", hipGetErrorString(e), grid);
}
```

```cpp
#include <hip/hip_runtime.h>
#include <hip/hip_cooperative_groups.h>
#include <cstdio>
#include <cstdint>
namespace cg = cooperative_groups;

#define LAS __attribute__((address_space(3)))
typedef unsigned short bf16_t;
typedef short bf16x8 __attribute__((ext_vector_type(8)));
typedef short s16x4 __attribute__((ext_vector_type(4)));
typedef float f32x2 __attribute__((ext_vector_type(2)));
typedef float f32x4 __attribute__((ext_vector_type(4)));
typedef float f32x16 __attribute__((ext_vector_type(16)));
typedef unsigned u32x2 __attribute__((ext_vector_type(2)));
typedef unsigned u32x4 __attribute__((ext_vector_type(4)));
typedef __bf16 bf16x2_t __attribute__((ext_vector_type(2)));

constexpr int TP = 16384, TS = 32768, TT = TP + TS, DM = 1024, NPROJ = 2304, DFF = 2816, NUP = 2 * DFF, NMEM = 5120;
constexpr float EPS = 1e-6f;
constexpr float LOG2E = 1.4426950408889634f;
constexpr float QSCALE = 0.125f * LOG2E;
constexpr float XSCALE = 0.0625f * LOG2E;

constexpr size_t MiB = 1u << 20;
constexpr size_t WS_SSQ = 0;
constexpr size_t WS_RSTD0 = 576 * 1024;
constexpr size_t WS_RSTDM = 768 * 1024;
constexpr size_t WS_TABP = 800 * 1024;
constexpr size_t WS_TABA = 1056 * 1024;
constexpr size_t WS_ONES = 1200 * 1024;
constexpr size_t WS_BAR = 1536 * 1024, BAR_BYTES = 16384;
constexpr size_t WS_WIN = 2 * MiB, WS_WOUT = 7 * MiB, WS_WXQ = 9 * MiB, WS_WXKV = 11 * MiB, WS_WXO = 15 * MiB, WS_WUP = 17 * MiB, WS_WDOWN = 28 * MiB;
constexpr size_t WS_MB = 34 * MiB, WS_KV = 44 * MiB;
constexpr size_t WS_R0 = 65 * MiB, WS_R1 = 162 * MiB, WS_RQ = 258 * MiB, WS_ACT = 162 * MiB, WS_END = 474 * MiB;

__device__ const double INVP[8] = {1.0, 0.19392274474868576, 0.03760603093086393, 0.007292664737217109, 0.001414213562373095, 0.0002742481756762073, 5.318295896944988e-05, 1.031338537721246e-05};
__device__ const double INVA[16] = {1.0, 0.5623413251903491, 0.31622776601683794, 0.1778279410038923, 0.1, 0.05623413251903491, 0.03162277660168379, 0.01778279410038923, 0.01, 0.005623413251903491,
                                    0.0031622776601683794, 0.0017782794100389228, 0.001, 0.0005623413251903491, 0.00031622776601683794, 0.00017782794100389227};

__device__ __forceinline__ unsigned pk_bf16(float lo, float hi) { f32x2 v = {lo, hi}; bf16x2_t b = __builtin_convertvector(v, bf16x2_t); return __builtin_bit_cast(unsigned, b); }
__device__ __forceinline__ float xhalf_max(float v) { const auto rr = __builtin_amdgcn_permlane32_swap(__float_as_uint(v), __float_as_uint(v), false, false); return __builtin_fmaxf(__uint_as_float(rr[0]), __uint_as_float(rr[1])); }
__device__ __forceinline__ float xrow4_sum(float v) { const auto r = __builtin_amdgcn_permlane16_swap(__float_as_uint(v), __float_as_uint(v), false, false);
    const float s = __uint_as_float(r[0]) + __uint_as_float(r[1]); const auto q = __builtin_amdgcn_permlane32_swap(__float_as_uint(s), __float_as_uint(s), false, false); return __uint_as_float(q[0]) + __uint_as_float(q[1]); }
__device__ __forceinline__ float xrow4_max(float v) { const auto r = __builtin_amdgcn_permlane16_swap(__float_as_uint(v), __float_as_uint(v), false, false);
    const float s = __builtin_fmaxf(__uint_as_float(r[0]), __uint_as_float(r[1])); const auto q = __builtin_amdgcn_permlane32_swap(__float_as_uint(s), __float_as_uint(s), false, false); return __builtin_fmaxf(__uint_as_float(q[0]), __uint_as_float(q[1])); }
__device__ __forceinline__ float row_prev(float v) { return __int_as_float(__builtin_amdgcn_update_dpp(__float_as_int(v), __float_as_int(v), 0x111, 0xf, 0xf, false)); }
__device__ __forceinline__ float row_next(float v) { return __int_as_float(__builtin_amdgcn_update_dpp(__float_as_int(v), __float_as_int(v), 0x101, 0xf, 0xf, false)); }
__device__ __forceinline__ float xhalf_sum(float v) { const auto rr = __builtin_amdgcn_permlane32_swap(__float_as_uint(v), __float_as_uint(v), false, false); return __uint_as_float(rr[0]) + __uint_as_float(rr[1]); }
__device__ __forceinline__ u32x4 widen_pair(u32x2 a, u32x2 b) {
    const auto r0 = __builtin_amdgcn_permlane32_swap(a.x, b.x, false, false), r1 = __builtin_amdgcn_permlane32_swap(a.y, b.y, false, false);
    u32x4 w; w.x = r0[0]; w.y = r1[0]; w.z = r0[1]; w.w = r1[1]; return w; }
__device__ __forceinline__ float wave_sum(float v) {
#pragma unroll
    for (int o = 1; o < 64; o <<= 1) v += __shfl_xor(v, o);
    return v;
}

namespace pg8 {
constexpr int BM = 256, BK = 64, HALF = 128, HTB = HALF * BK * 2, STAGE_BYTES = 8 * HTB, NXCD = 8, WGM = 4;
__host__ __device__ __forceinline__ int lds_byte(int r, int c) { const int st = (r >> 4) * 2 + (c >> 5), rr = r & 15, cc = c & 31, ob = rr * 64 + cc * 2; return st * 1024 + (ob ^ (((ob >> 9) & 1) << 5)); }
__host__ __device__ __forceinline__ void stage_rc(int b, int& R, int& C) { const int st = b / 1024, sb = b % 1024, swz = sb ^ (((sb >> 9) & 1) << 5); R = (st >> 1) * 16 + swz / 64; C = (st & 1) * 32 + (swz % 64) / 2; }
__host__ __device__ __forceinline__ int perm32(int rho) { const int n = rho >> 4, i = rho & 15; return 8 * (i >> 2) + 4 * n + (i & 3); }

struct Unit { int pm, pn; };
struct Gemm { const bf16_t* A; const bf16_t* Bt; int K; size_t a_tstep, a_hstep; int lda = 0, ldb = 0; };

struct StaticOrder {
    int nM, nN, nwg, G, c;
    __device__ void init(int nM_, int nN_, int G_, int c_) { nM = nM_; nN = nN_; nwg = nM * nN; G = G_; c = c_; }
    __device__ bool next(int i, Unit& u) const {
        const long L = (long)i * G + c; if (L >= nwg) return false;
        int wgid = (int)L; { const int q = nwg / NXCD, r = nwg % NXCD, xcd = wgid % NXCD, off = wgid / NXCD; wgid = (xcd < r ? xcd * (q + 1) : r * (q + 1) + (xcd - r) * q) + off; }
        const int nig = WGM * nN, gid = wgid / nig, fm = gid * WGM, gsz = (nM - fm) < WGM ? (nM - fm) : WGM;
        u.pm = fm + ((wgid % nig) % gsz); u.pn = (wgid % nig) / gsz; return true;
    }
};

__device__ __forceinline__ int mem_batch(int pm) { const int t0 = pm * 256; return (t0 < TP) ? (t0 >> 12) : 4 + ((t0 - TP) >> 11); }
template <int MAP> __device__ __forceinline__ size_t a_unit_off(const Gemm& g, const Unit& u) { if (MAP == 0) return (size_t)u.pm * g.a_tstep;
    return (size_t)(unsigned)__builtin_amdgcn_readfirstlane((int)(((unsigned)u.pm * 256u * 1024u + (unsigned)u.pn * 256u) * 2u)); }
template <int MAP> __device__ __forceinline__ size_t b_unit_off(const Gemm& g, const Unit& u, size_t tstepB) {
    if (MAP == 0) return (size_t)u.pn * tstepB;
    const unsigned mb = (unsigned)mem_batch(u.pm);
    return (size_t)(unsigned)__builtin_amdgcn_readfirstlane((int)(MAP == 1 ? (mb * 256u * 1024u + (unsigned)u.pn * 256u) * 2u : ((unsigned)u.pn * 256u * (unsigned)NMEM + mb * 256u) * 2u)); }

template <class Epi, bool CONV, int MAP = 0>
__device__ __forceinline__ void gemm_phase(LAS unsigned char* lds, const Gemm g, const StaticOrder& S, const Epi& E) {
    int tid = threadIdx.x; asm volatile("" : "+v"(tid));
    const int wid = __builtin_amdgcn_readfirstlane(tid >> 6), lane = tid & 63, wr = wid >> 2, wc = wid & 3, fr = lane & 15, fq = lane >> 4;
    const int K = g.K, nt = K / BK, lda = g.lda ? g.lda : K, ldb = g.ldb ? g.ldb : K;
    unsigned voffA[2], voffB[2];
#pragma unroll
    for (int i = 0; i < 2; ++i) { int R, C; stage_rc(tid * 16 + i * 8192, R, C); const int Rb = Epi::PERM ? ((R & ~31) + perm32(R & 31)) : R;
        const int Ra = CONV ? (126 * (R >> 6) + 8 * (R & 15) + ((R >> 4) & 3)) : R;
        voffA[i] = (unsigned)(Ra * lda + C) * 2u; voffB[i] = (unsigned)(Rb * ldb + C) * 2u; }
    const size_t kstep = (size_t)(BK * 2);
    const size_t hstepB = (size_t)HALF * ldb * 2, tstepB = 2 * hstepB;
    const size_t hstepA = g.a_hstep;
    const unsigned ldsw = (unsigned)wid * 1024u;
    const int aoff = lds_byte(wr * 64 + fr, fq * 8), boff = lds_byte(wc * 32 + fr, fq * 8);
#define PG8_SA(b, h) (((b) * 2 + (h)) * HTB)
#define PG8_SB(b, h) ((4 + (b) * 2 + (h)) * HTB)
#define PG8_STAGE(bufoff, gbase, voff) do { _Pragma("unroll") for (int _i = 0; _i < 2; ++_i) \
        __builtin_amdgcn_global_load_lds((const unsigned*)((const char*)(gbase) + (voff)[_i]), (LAS unsigned*)(lds + (bufoff) + ldsw + _i * 8192), 16, 0, 0); } while (0)
#define PG8_LDA(dst, b, h) do { _Pragma("unroll") for (int m = 0; m < 4; ++m) _Pragma("unroll") for (int k = 0; k < 2; ++k) dst[m][k] = *(const LAS bf16x8*)(lds + PG8_SA(b, h) + aoff + m * 2048 + k * 1024); } while (0)
#define PG8_LDB(dst, b, h) do { _Pragma("unroll") for (int n = 0; n < 2; ++n) _Pragma("unroll") for (int k = 0; k < 2; ++k) dst[n][k] = *(const LAS bf16x8*)(lds + PG8_SB(b, h) + boff + n * 2048 + k * 1024); } while (0)
#define PG8_MMA(ai, bj, At, Bt) do { __builtin_amdgcn_s_setprio(1); _Pragma("unroll") for (int m = 0; m < 4; ++m) _Pragma("unroll") for (int n = 0; n < 2; ++n) _Pragma("unroll") for (int k = 0; k < 2; ++k) \
        acc[ai][bj][m][n] = __builtin_amdgcn_mfma_f32_16x16x32_bf16(Bt[n][k], At[m][k], acc[ai][bj][m][n], 0, 0, 0); __builtin_amdgcn_s_setprio(0); } while (0)
#define PG8_WAIT_V(n) asm volatile("s_waitcnt vmcnt(" #n ")" ::: "memory")
#define PG8_WAIT_L(n) asm volatile("s_waitcnt lgkmcnt(" #n ")" ::: "memory")
#define PG8_BAR __builtin_amdgcn_s_barrier()
#define PG8_SCHED __builtin_amdgcn_sched_barrier(0)
    Unit cur, nxt; int ui = 0;
    if (!S.next(0, cur)) return;
    f32x4 acc[2][2][4][2];
#pragma unroll
    for (int a = 0; a < 2; ++a)
#pragma unroll
        for (int b = 0; b < 2; ++b)
#pragma unroll
            for (int m = 0; m < 4; ++m)
#pragma unroll
                for (int n = 0; n < 2; ++n) acc[a][b][m][n] = (f32x4){0.f, 0.f, 0.f, 0.f};
    bf16x8 At[4][2], B0[2][2], B1[2][2];
    const char* cA = (const char*)g.A + a_unit_off<MAP>(g, cur); const char* cB = (const char*)g.Bt + b_unit_off<MAP>(g, cur, tstepB);
    PG8_STAGE(PG8_SB(0, 0), cB, voffB); PG8_STAGE(PG8_SB(0, 1), cB + hstepB, voffB); PG8_STAGE(PG8_SA(0, 0), cA, voffA); PG8_STAGE(PG8_SA(0, 1), cA + hstepA, voffA);
    if (wr == 1) PG8_BAR;
    PG8_WAIT_V(2); PG8_BAR;
    PG8_STAGE(PG8_SB(1, 0), cB + kstep, voffB); PG8_STAGE(PG8_SA(1, 0), cA + kstep, voffA); PG8_STAGE(PG8_SB(1, 1), cB + hstepB + kstep, voffB);
    PG8_WAIT_V(6); PG8_BAR;
    for (;;) {
        const bool has_next = S.next(ui + 1, nxt);
        const char* nA = has_next ? (const char*)g.A + a_unit_off<MAP>(g, nxt) : cA; const char* nB = has_next ? (const char*)g.Bt + b_unit_off<MAP>(g, nxt, tstepB) : cB;
        for (int t = 0; t < nt; t += 2) {
            const bool last = (t == nt - 2);
            const char* a1 = cA + (size_t)(t + 1) * kstep;
            const char* a2 = last ? nA : cA + (size_t)(t + 2) * kstep; const char* b2 = last ? nB : cB + (size_t)(t + 2) * kstep;
            const char* a3 = a2 + kstep; const char* b3 = b2 + kstep;
            PG8_LDB(B0, 0, 0); PG8_LDB(B1, 0, 1); PG8_SCHED; PG8_LDA(At, 0, 0); PG8_STAGE(PG8_SA(1, 1), a1 + hstepA, voffA);
            PG8_WAIT_V(8); PG8_WAIT_L(0); PG8_BAR; PG8_MMA(0, 0, At, B0); PG8_MMA(0, 1, At, B1); PG8_BAR; PG8_SCHED;
            PG8_LDA(At, 0, 1); PG8_STAGE(PG8_SB(0, 0), b2, voffB); PG8_STAGE(PG8_SB(0, 1), b2 + hstepB, voffB); PG8_STAGE(PG8_SA(0, 0), a2, voffA);
            PG8_WAIT_V(8); PG8_WAIT_L(0); PG8_BAR; PG8_MMA(1, 0, At, B0); PG8_MMA(1, 1, At, B1); PG8_BAR; PG8_SCHED;
            PG8_LDB(B0, 1, 0); PG8_LDB(B1, 1, 1); PG8_SCHED; PG8_LDA(At, 1, 0); PG8_STAGE(PG8_SA(0, 1), a2 + hstepA, voffA);
            PG8_WAIT_V(8); PG8_WAIT_L(0); PG8_BAR; PG8_MMA(0, 0, At, B0); PG8_MMA(0, 1, At, B1); PG8_BAR; PG8_SCHED;
            PG8_LDA(At, 1, 1); PG8_STAGE(PG8_SB(1, 0), b3, voffB); PG8_STAGE(PG8_SB(1, 1), b3 + hstepB, voffB); PG8_STAGE(PG8_SA(1, 0), a3, voffA);
            PG8_WAIT_V(8); PG8_WAIT_L(0); PG8_BAR; PG8_MMA(1, 0, At, B0); PG8_MMA(1, 1, At, B1); PG8_BAR; PG8_SCHED;
        }
        if (wr == 0) PG8_BAR;
        E(acc, cur, wr, wc, fr, fq);
        if (!has_next) break;
#pragma unroll
        for (int a = 0; a < 2; ++a)
#pragma unroll
            for (int b = 0; b < 2; ++b)
#pragma unroll
                for (int m = 0; m < 4; ++m)
#pragma unroll
                    for (int n = 0; n < 2; ++n) acc[a][b][m][n] = (f32x4){0.f, 0.f, 0.f, 0.f};
        cur = nxt; cA = nA; cB = nB; ++ui;
        if (wr == 1) PG8_BAR;
    }
    PG8_WAIT_V(0);
    PG8_BAR;
#undef PG8_SA
#undef PG8_SB
#undef PG8_STAGE
#undef PG8_LDA
#undef PG8_LDB
#undef PG8_MMA
#undef PG8_WAIT_V
#undef PG8_WAIT_L
#undef PG8_BAR
#undef PG8_SCHED
}

typedef const f32x4 (&AccRef)[2][2][4][2];

constexpr float RVP[8] = {1.591549431e-01f, 3.086376340e-02f, 5.985185713e-03f, 1.160663641e-03f, 2.250790790e-04f, 4.364795279e-05f, 8.464330808e-06f, 1.641426263e-06f};
constexpr float RVA[16] = {1.591549431e-01f, 8.949940161e-02f, 5.032921210e-02f, 2.830219583e-02f, 1.591549431e-02f, 8.949940161e-03f, 5.032921210e-03f, 2.830219583e-03f,
                           1.591549431e-03f, 8.949940161e-04f, 5.032921210e-04f, 2.830219583e-04f, 1.591549431e-04f, 8.949940161e-05f, 5.032921210e-05f, 2.830219583e-05f};
struct EpiInProj {
    static constexpr bool PERM = true;
    bf16_t* QKV; const float* rstd0; const f32x2* tabP; const f32x2* tabA; const float* gq_g; const float* gk_g;
    __device__ __forceinline__ void operator()(AccRef acc, const Unit& u, int wr, int wc, int fr_, int fq_) const {
        int fr = fr_, fq = fq_; asm volatile("" : "+v"(fr), "+v"(fq));
        const int U = u.pn * 4 + wc;
        const int type = (U < 16) ? 0 : (U < 24) ? 1 : (U < 32) ? 2 : (U < 34) ? 3 : 1;
        const float sc = (U < 8 || (U >= 24 && U < 32)) ? QSCALE : 1.0f;
        float g0[8], g1[8];
        if (type >= 2) { const float* g = (type == 2) ? gq_g : gk_g;
#pragma unroll
            for (int e = 0; e < 8; ++e) { g0[e] = g[8 * fq + e]; g1[e] = g[32 + 8 * fq + e]; } }
        float rs8[8];
#pragma unroll
        for (int i = 0; i < 8; ++i) rs8[i] = rstd0[u.pm * BM + (i >> 2) * HALF + wr * 64 + (i & 3) * 16 + fr];
#pragma unroll
        for (int ai = 0; ai < 2; ++ai)
#pragma unroll
            for (int m = 0; m < 4; ++m) {
                const int t = u.pm * BM + ai * HALF + wr * 64 + m * 16 + fr;
                const float rs = rs8[ai * 4 + m];
                const int pos = (t < TP) ? (t & 4095) : (t & 2047);
                float v0[8], v1[8];
#pragma unroll
                for (int e = 0; e < 8; ++e) { v0[e] = acc[ai][0][m][e >> 2][e & 3] * rs; v1[e] = acc[ai][1][m][e >> 2][e & 3] * rs; }
                if (type == 0) {
#pragma unroll
                    for (int e = 0; e < 8; ++e) {
                        const float pr = __shfl_xor(v0[e], 16);
                        float rv = (float)pos * RVP[e]; rv -= __builtin_floorf(rv);
                        const float csx = __builtin_amdgcn_cosf(rv), csy = __builtin_amdgcn_sinf(rv);
                        const float r0 = v0[e] * csx - pr * csy, r1 = pr * csy + v0[e] * csx;
                        v0[e] = (fq == 0) ? r0 : (fq == 1) ? r1 : v0[e];
                    }
                } else if (type >= 2) {
                    float ss = 0.f;
#pragma unroll
                    for (int e = 0; e < 8; ++e) ss += v0[e] * v0[e] + v1[e] * v1[e];
                    ss = xrow4_sum(ss);
                    const float rn = 1.0f / sqrtf(ss * (1.0f / 64.0f) + EPS);
                    const int prow = pos >> 6, pcol = pos & 63;
#pragma unroll
                    for (int e = 0; e < 8; ++e) {
                        const float a0 = v0[e] * rn * g0[e], a1 = v1[e] * rn * g1[e];
                        const float p0 = __shfl_xor(a0, 32), p1 = __shfl_xor(a1, 32);
                        const float rva = (fq & 1) ? RVA[8 + e] : RVA[e];
                        const float rr = (float)prow * rva, rc = (float)pcol * rva;
                        const float c0x = __builtin_amdgcn_cosf(rr), c0y = __builtin_amdgcn_sinf(rr), c1x = __builtin_amdgcn_cosf(rc), c1y = __builtin_amdgcn_sinf(rc);
                        v0[e] = (fq < 2) ? (a0 * c0x - p0 * c0y) : (p0 * c0y + a0 * c0x);
                        v1[e] = (fq < 2) ? (a1 * c1x - p1 * c1y) : (p1 * c1y + a1 * c1x);
                    }
                }
                bf16_t* dst = QKV + (size_t)t * NPROJ + 64 * U + 8 * fq;
                u32x4 w0, w1;
                w0.x = pk_bf16(v0[0] * sc, v0[1] * sc); w0.y = pk_bf16(v0[2] * sc, v0[3] * sc); w0.z = pk_bf16(v0[4] * sc, v0[5] * sc); w0.w = pk_bf16(v0[6] * sc, v0[7] * sc);
                w1.x = pk_bf16(v1[0] * sc, v1[1] * sc); w1.y = pk_bf16(v1[2] * sc, v1[3] * sc); w1.z = pk_bf16(v1[4] * sc, v1[5] * sc); w1.w = pk_bf16(v1[6] * sc, v1[7] * sc);
                *(u32x4*)dst = w0; *(u32x4*)(dst + 32) = w1;
            }
    }
};

template <bool FROM_SSQ> struct EpiScaleBf16 {
    static constexpr bool PERM = true;
    bf16_t* O; int ldc; const float* rs; float sc;
    __device__ __forceinline__ void operator()(AccRef acc, const Unit& u, int wr, int wc, int fr_, int fq_) const {
        int fr = fr_, fq = fq_; asm volatile("" : "+v"(fr), "+v"(fq));
        const int col0 = u.pn * BM + wc * 32 + 8 * fq;
        float s8[8];
#pragma unroll
        for (int i = 0; i < 8; ++i) s8[i] = rs[u.pm * BM + (i >> 2) * HALF + wr * 64 + (i & 3) * 16 + fr];
#pragma unroll
        for (int ai = 0; ai < 2; ++ai)
#pragma unroll
            for (int m = 0; m < 4; ++m) {
                const int row = u.pm * BM + ai * HALF + wr * 64 + m * 16 + fr;
                float s = s8[ai * 4 + m]; if (FROM_SSQ) s = 1.0f / sqrtf(s * (1.0f / 1024.0f) + EPS); s *= sc;
                bf16_t* rowp = O + (size_t)row * ldc + col0;
#pragma unroll
                for (int bj = 0; bj < 2; ++bj) { const f32x4 a0 = acc[ai][bj][m][0] * s, a1 = acc[ai][bj][m][1] * s;
                    u32x4 w; w.x = pk_bf16(a0[0], a0[1]); w.y = pk_bf16(a0[2], a0[3]); w.z = pk_bf16(a1[0], a1[1]); w.w = pk_bf16(a1[2], a1[3]);
                    *(u32x4*)(rowp + bj * HALF) = w; }
            }
    }
};

struct EpiColScaleBf16 {
    static constexpr bool PERM = true;
    bf16_t* O; int ldc; const float* cs;
    __device__ __forceinline__ void operator()(AccRef acc, const Unit& u, int wr, int wc, int fr_, int fq_) const {
        int fr = fr_, fq = fq_; asm volatile("" : "+v"(fr), "+v"(fq));
        const int col0 = u.pn * BM + wc * 32 + 8 * fq;
        f32x4 c0[2], c1[2];
#pragma unroll
        for (int bj = 0; bj < 2; ++bj) { c0[bj] = *(const f32x4*)(cs + col0 + bj * HALF); c1[bj] = *(const f32x4*)(cs + col0 + bj * HALF + 4); }
#pragma unroll
        for (int ai = 0; ai < 2; ++ai)
#pragma unroll
            for (int m = 0; m < 4; ++m) {
                const int row = u.pm * BM + ai * HALF + wr * 64 + m * 16 + fr;
                bf16_t* rowp = O + (size_t)row * ldc + col0;
#pragma unroll
                for (int bj = 0; bj < 2; ++bj) { const f32x4 a0 = acc[ai][bj][m][0] * c0[bj], a1 = acc[ai][bj][m][1] * c1[bj];
                    u32x4 w; w.x = pk_bf16(a0[0], a0[1]); w.y = pk_bf16(a0[2], a0[3]); w.z = pk_bf16(a1[0], a1[1]); w.w = pk_bf16(a1[2], a1[3]);
                    *(u32x4*)(rowp + bj * HALF) = w; }
            }
    }
};
struct EpiSoftmaxP {
    static constexpr bool PERM = true;
    bf16_t* O; LAS f32x2* xch;
    __device__ __forceinline__ void operator()(f32x4 (&acc)[2][2][4][2], const Unit& u, int wr, int wc, int fr_, int fq_) const {
        int fr = fr_, fq = fq_; asm volatile("" : "+v"(fr), "+v"(fq));
        LAS f32x2* X = xch + ((u.pm + u.pn) & 1) * 1024;
#pragma unroll
        for (int ai = 0; ai < 2; ++ai)
#pragma unroll
            for (int m = 0; m < 4; ++m) {
                float mx = -INFINITY;
#pragma unroll
                for (int bj = 0; bj < 2; ++bj)
#pragma unroll
                    for (int n = 0; n < 2; ++n) { const f32x4 v = acc[ai][bj][m][n]; mx = fmaxf(mx, fmaxf(fmaxf(v[0], v[1]), fmaxf(v[2], v[3]))); }
                mx = xrow4_max(mx);
                float sm = 0.f;
#pragma unroll
                for (int bj = 0; bj < 2; ++bj)
#pragma unroll
                    for (int n = 0; n < 2; ++n) { f32x4 v = acc[ai][bj][m][n];
                        v[0] = __builtin_amdgcn_exp2f(v[0] - mx); v[1] = __builtin_amdgcn_exp2f(v[1] - mx); v[2] = __builtin_amdgcn_exp2f(v[2] - mx); v[3] = __builtin_amdgcn_exp2f(v[3] - mx);
                        sm += (v[0] + v[1]) + (v[2] + v[3]); acc[ai][bj][m][n] = v; }
                sm = xrow4_sum(sm);
                if (fq == 0) X[(ai * HALF + wr * 64 + m * 16 + fr) * 4 + wc] = (f32x2){mx, sm};
            }
        asm volatile("s_waitcnt lgkmcnt(0)" ::: "memory"); __builtin_amdgcn_s_barrier(); asm volatile("" ::: "memory");
        const int col0 = u.pn * BM + wc * 32 + 8 * fq;
#pragma unroll
        for (int ai = 0; ai < 2; ++ai)
#pragma unroll
            for (int m = 0; m < 4; ++m) {
                const int r = ai * HALF + wr * 64 + m * 16 + fr;
                const f32x2 a = X[r * 4 + 0], b = X[r * 4 + 1], c = X[r * 4 + 2], d = X[r * 4 + 3];
                const float M = fmaxf(fmaxf(a.x, b.x), fmaxf(c.x, d.x));
                const float L = (a.y * __builtin_amdgcn_exp2f(a.x - M) + b.y * __builtin_amdgcn_exp2f(b.x - M)) + (c.y * __builtin_amdgcn_exp2f(c.x - M) + d.y * __builtin_amdgcn_exp2f(d.x - M));
                const float mine = (wc == 0) ? a.x : (wc == 1) ? b.x : (wc == 2) ? c.x : d.x;
                const float f = __builtin_amdgcn_exp2f(mine - M) * __builtin_amdgcn_rcpf(L);
                bf16_t* rowp = O + (size_t)(u.pm * BM + r) * DM + col0;
#pragma unroll
                for (int bj = 0; bj < 2; ++bj) { const f32x4 a0 = acc[ai][bj][m][0] * f, a1 = acc[ai][bj][m][1] * f;
                    u32x4 w; w.x = pk_bf16(a0[0], a0[1]); w.y = pk_bf16(a0[2], a0[3]); w.z = pk_bf16(a1[0], a1[1]); w.w = pk_bf16(a1[2], a1[3]);
                    *(u32x4*)(rowp + bj * HALF) = w; }
            }
    }
};
template <int SRC> struct EpiResid {
    static constexpr bool PERM = true;
    const float* xin_p; const float* xin_s; const bf16_t* xsrc; bf16_t* xb; float* ssq;
    __device__ __forceinline__ void operator()(AccRef acc, const Unit& u, int wr, int wc, int fr, int fq) const {
        static_assert(SRC == 1, "the residual stream is bf16 everywhere");
        const int col0 = u.pn * BM + wc * 32 + 8 * fq;
        u32x4 rw[8][2];
#pragma unroll
        for (int i = 0; i < 8; ++i) { const int t = u.pm * BM + (i >> 2) * HALF + wr * 64 + (i & 3) * 16 + fr;
#pragma unroll
            for (int bj = 0; bj < 2; ++bj) rw[i][bj] = *(const u32x4*)(xsrc + (size_t)t * DM + col0 + bj * HALF); }
        __builtin_amdgcn_sched_barrier(0);
        float ssr[8];
#pragma unroll
        for (int i = 0; i < 8; ++i) {
            const int ai = i >> 2, m = i & 3, t = u.pm * BM + ai * HALF + wr * 64 + m * 16 + fr;
            float ss = 0.f;
#pragma unroll
            for (int bj = 0; bj < 2; ++bj) { const int c = col0 + bj * HALF; const u32x4 w = rw[i][bj];
                const f32x4 r0 = {__uint_as_float(w.x << 16), __uint_as_float(w.x & 0xffff0000u), __uint_as_float(w.y << 16), __uint_as_float(w.y & 0xffff0000u)};
                const f32x4 r1 = {__uint_as_float(w.z << 16), __uint_as_float(w.z & 0xffff0000u), __uint_as_float(w.w << 16), __uint_as_float(w.w & 0xffff0000u)};
                const f32x4 v0 = r0 + acc[ai][bj][m][0], v1 = r1 + acc[ai][bj][m][1];
                u32x4 o; o.x = pk_bf16(v0[0], v0[1]); o.y = pk_bf16(v0[2], v0[3]); o.z = pk_bf16(v1[0], v1[1]); o.w = pk_bf16(v1[2], v1[3]);
                *(u32x4*)(xb + (size_t)t * DM + c) = o;
                ss += ((v0[0] * v0[0] + v0[1] * v0[1]) + (v0[2] * v0[2] + v0[3] * v0[3])) + ((v1[0] * v1[0] + v1[1] * v1[1]) + (v1[2] * v1[2] + v1[3] * v1[3])); }
            ssr[i] = xrow4_sum(ss);
        }
        if (fq == 0) {
#pragma unroll
            for (int i = 0; i < 8; ++i) unsafeAtomicAdd(ssq + u.pm * BM + (i >> 2) * HALF + wr * 64 + (i & 3) * 16 + fr, ssr[i]);
        }
    }
};

struct EpiConvGate {
    static constexpr bool PERM = true;
    bf16_t* ACT; const float* ssq2; const float* conv_w; const float* conv_b;
    __device__ __forceinline__ void operator()(AccRef acc, const Unit& u, int wr, int wc, int fr_, int fq_) const {
        int fr = fr_, fq = fq_; asm volatile("" : "+v"(fr), "+v"(fq));
        const int tb = 252 * u.pm - 1 + 126 * wr + 8 * fr;
        float rs[8]; unsigned firstm = 0u, lastm = 0u, okm = 0u;
#pragma unroll
        for (int i = 0; i < 8; ++i) { const int t = tb + i; const bool valid = (t >= 0) && (t < TT);
            const int tc = valid ? t : 0; const float s = 1.0f / sqrtf(ssq2[tc] * (1.0f / 1024.0f) + EPS); rs[i] = valid ? s : 0.f;
            const int sm = (t < TP) ? 4095 : 2047;
            if ((t & sm) == 0) firstm |= 1u << i; if ((t & sm) == sm) lastm |= 1u << i;
            const bool halo = (fr == 0 && i == 0) || (fr == 15 && i == 7);
            if (valid && !halo) okm |= 1u << i; }
        const int fcol0 = 128 * u.pn + 32 * wc + 8 * fq;
#pragma unroll
        for (int n = 0; n < 2; ++n) {
            const int fc = fcol0 + 4 * n;
            const f32x4 wa0 = *(const f32x4*)(conv_w + fc), wa1 = *(const f32x4*)(conv_w + NUP + fc), wa2 = *(const f32x4*)(conv_w + 2 * NUP + fc), ba = *(const f32x4*)(conv_b + fc);
            const f32x4 wb0 = *(const f32x4*)(conv_w + DFF + fc), wb1 = *(const f32x4*)(conv_w + NUP + DFF + fc), wb2 = *(const f32x4*)(conv_w + 2 * NUP + DFF + fc), bb = *(const f32x4*)(conv_b + DFF + fc);
            float res[8][4];
#pragma unroll
            for (int j = 0; j < 4; ++j) {
                float ua[8], ub[8];
#pragma unroll
                for (int i = 0; i < 8; ++i) { ua[i] = acc[i >> 2][0][i & 3][n][j] * rs[i]; ub[i] = acc[i >> 2][1][i & 3][n][j] * rs[i]; }
                const float uap = row_prev(ua[7]), uan = row_next(ua[0]);
                const float ubp = row_prev(ub[7]), ubn = row_next(ub[0]);
#pragma unroll
                for (int i = 0; i < 8; ++i) {
                    float pa = (i == 0) ? uap : ua[i > 0 ? i - 1 : 0], na = (i == 7) ? uan : ua[i < 7 ? i + 1 : 7];
                    float pb = (i == 0) ? ubp : ub[i > 0 ? i - 1 : 0], nb = (i == 7) ? ubn : ub[i < 7 ? i + 1 : 7];
                    if (firstm & (1u << i)) { pa = 0.f; pb = 0.f; }
                    if (lastm & (1u << i)) { na = 0.f; nb = 0.f; }
                    const float ca = wa0[j] * pa + wa1[j] * ua[i] + wa2[j] * na + ba[j];
                    const float cb = wb0[j] * pb + wb1[j] * ub[i] + wb2[j] * nb + bb[j];
                    const float sg = ca * __builtin_amdgcn_rcpf(1.0f + __builtin_amdgcn_exp2f(-ca * LOG2E));
                    res[i][j] = sg * cb;
                }
            }
#pragma unroll
            for (int i = 0; i < 8; ++i) if (okm & (1u << i)) { u32x2 w; w.x = pk_bf16(res[i][0], res[i][1]); w.y = pk_bf16(res[i][2], res[i][3]);
                *(u32x2*)(ACT + (size_t)(tb + i) * DFF + fc) = w; }
        }
    }
};
}

template <int MODE> struct ACfg {
    static constexpr int DQK = (MODE == 2) ? 256 : 64;
    static constexpr int NKC = (MODE == 0) ? 8 : (MODE == 1) ? 16 : 32;
    static constexpr int DV = (MODE == 0) ? 64 : (MODE == 1) ? 128 : 256;
    static constexpr int DVW = (MODE == 0) ? 64 : 128;
    static constexpr int KBYTES = NKC * 1024, VBYTES = DV * 128, STAGE = KBYTES + VBYTES;
    static constexpr int NKI = NKC / 8, NVI = DV / 64, NS = DQK / 16, NC = DVW / 32;
    static constexpr bool PREFETCH = (MODE != 2);
};
constexpr int XCH_OFF = 65536;

template <int MODE>
__device__ __forceinline__ void attn_unit(LAS unsigned char* lds, const bf16_t* Qp, int ldq, const bf16_t* Kb, int ldk, const bf16_t* Vb, int ldv, int NT,
                                          bf16_t* Op, int ldo, float lam, const float* subg) {
    typedef ACfg<MODE> C;
    int tid = threadIdx.x; asm volatile("" : "+v"(tid));
    const int lane = tid & 63, wid = __builtin_amdgcn_readfirstlane(tid >> 6), r32 = lane & 31, hi = lane >> 5;
    const int kimg = (MODE == 1) ? (wid >> 2) : 0;
    u32x4 kreg[C::NKI], vreg[C::NVI];
    const bf16_t* kg = Kb + (size_t)lane * ldk + wid * 8;
    const bf16_t* vg = Vb + (size_t)(16 * (wid & 3) + (lane >> 2)) * ldv + 32 * (wid >> 2) + (lane & 3) * 8;
#define AT_LOADS(i) do { if ((i) < NT) { _Pragma("unroll") for (int j = 0; j < C::NKI; ++j) kreg[j] = *(const u32x4*)(kg + (size_t)(i) * 64 * ldk + 64 * j); } \
        if ((i) >= 1 && (i) <= NT) { _Pragma("unroll") for (int j = 0; j < C::NVI; ++j) vreg[j] = *(const u32x4*)(vg + (size_t)((i) - 1) * 64 * ldv + 64 * j); } } while (0)
#define AT_STORES(i) do { LAS unsigned char* sb_ = lds + ((i) & 1) * C::STAGE; if ((i) < NT) { _Pragma("unroll") for (int j = 0; j < C::NKI; ++j) *(LAS u32x4*)(sb_ + (tid + 512 * j) * 16) = kreg[j]; } \
        if ((i) >= 1 && (i) <= NT) { _Pragma("unroll") for (int j = 0; j < C::NVI; ++j) *(LAS u32x4*)(sb_ + C::KBYTES + (tid + 512 * j) * 16) = vreg[j]; } } while (0)
#define MX3(a, b, c) __builtin_fmaxf(__builtin_fmaxf((a), (b)), (c))
#define AT_ROWMAX(P0, P1, OUT) do { float a_ = MX3(P0[0], P0[1], P1[0]), b_ = MX3(P0[2], P0[3], P1[1]); a_ = MX3(a_, P1[2], P1[3]); \
        _Pragma("unroll") for (int r = 4; r < 16; r += 4) { a_ = MX3(a_, P0[r], P0[r + 1]); b_ = MX3(b_, P0[r + 2], P0[r + 3]); a_ = MX3(a_, P1[r], P1[r + 1]); b_ = MX3(b_, P1[r + 2], P1[r + 3]); } \
        OUT = xhalf_max(__builtin_fmaxf(a_, b_)); } while (0)
#define AT_QK(P0, P1, SB, CIN) do { _Pragma("unroll") for (int s = 0; s < C::NS; ++s) { \
        const bf16x8 a0_ = *(const LAS bf16x8*)((SB) + koff + s * 2048), a1_ = *(const LAS bf16x8*)((SB) + koff + s * 2048 + 512); \
        if (s == 0) { P0 = __builtin_amdgcn_mfma_f32_32x32x16_bf16(a0_, qf[0], CIN, 0, 0, 0); P1 = __builtin_amdgcn_mfma_f32_32x32x16_bf16(a1_, qf[0], CIN, 0, 0, 0); } \
        else { P0 = __builtin_amdgcn_mfma_f32_32x32x16_bf16(a0_, qf[s], P0, 0, 0, 0); P1 = __builtin_amdgcn_mfma_f32_32x32x16_bf16(a1_, qf[s], P1, 0, 0, 0); } } } while (0)
#define AT_PV1(ks, PW, SB) do { const bf16x8 pb_ = __builtin_bit_cast(bf16x8, PW); _Pragma("unroll") for (int c = 0; c < C::NC; ++c) { \
        const s16x4 lo_ = __builtin_bit_cast(s16x4, __builtin_amdgcn_ds_read_tr16_b64_v4i16((LAS s16x4*)((SB) + voff + c * 4096 + (ks) * 1024))); \
        const s16x4 h4_ = __builtin_bit_cast(s16x4, __builtin_amdgcn_ds_read_tr16_b64_v4i16((LAS s16x4*)((SB) + voff + c * 4096 + (ks) * 1024 + 512))); \
        const bf16x8 vf_ = (bf16x8){lo_[0], lo_[1], lo_[2], lo_[3], h4_[0], h4_[1], h4_[2], h4_[3]}; \
        o[c] = __builtin_amdgcn_mfma_f32_32x32x16_bf16(vf_, pb_, o[c], 0, 0, 0); } } while (0)
    const f32x16 zero16 = {0.f, 0.f, 0.f, 0.f, 0.f, 0.f, 0.f, 0.f, 0.f, 0.f, 0.f, 0.f, 0.f, 0.f, 0.f, 0.f};
    const int koff = kimg * 8192 + hi * 1024 + r32 * 16;
    const int voff = C::KBYTES + ((lane >> 4) & 1) * 32 + (lane & 3) * 8 + (4 * hi + ((lane & 15) >> 2)) * 64;
    AT_LOADS(0);
    bf16x8 qf[C::NS];
#pragma unroll
    for (int s = 0; s < C::NS; ++s) qf[s] = *(const bf16x8*)(Qp + (size_t)r32 * ldq + 16 * s + 8 * hi);
    AT_STORES(0);
    AT_LOADS(1);
    __syncthreads();
    f32x16 o[C::NC];
#pragma unroll
    for (int c = 0; c < C::NC; ++c)
#pragma unroll
        for (int r = 0; r < 16; ++r) o[c][r] = 0.f;
    f32x16 s0, s1, n0, n1;
    AT_QK(s0, s1, lds, zero16);
    AT_STORES(1);
    AT_LOADS(2);
    float m_ref, l_run = 0.f;
    AT_ROWMAX(s0, s1, m_ref);
    f32x16 negm;
#pragma unroll
    for (int r = 0; r < 16; ++r) { s0[r] -= m_ref; s1[r] -= m_ref; negm[r] = -m_ref; }
    __syncthreads();
    if (wid >= 4) __builtin_amdgcn_s_setprio(1);
#pragma clang loop unroll(disable)
    for (int t = 0; t < NT; ++t) {
        const LAS unsigned char* sb = lds + ((t + 1) & 1) * C::STAGE;
        u32x4 pw0, pw1, pw2, pw3; float ls = 0.f;
        AT_QK(n0, n1, sb, negm);
#pragma unroll
        for (int r = 0; r < 16; ++r) { s0[r] = __builtin_amdgcn_exp2f(s0[r]); s1[r] = __builtin_amdgcn_exp2f(s1[r]); ls += s0[r] + s1[r]; }
        l_run += ls;
        pw0.x = pk_bf16(s0[0], s0[1]); pw0.y = pk_bf16(s0[2], s0[3]); pw0.z = pk_bf16(s0[4], s0[5]); pw0.w = pk_bf16(s0[6], s0[7]);
        pw1.x = pk_bf16(s0[8], s0[9]); pw1.y = pk_bf16(s0[10], s0[11]); pw1.z = pk_bf16(s0[12], s0[13]); pw1.w = pk_bf16(s0[14], s0[15]);
        pw2.x = pk_bf16(s1[0], s1[1]); pw2.y = pk_bf16(s1[2], s1[3]); pw2.z = pk_bf16(s1[4], s1[5]); pw2.w = pk_bf16(s1[6], s1[7]);
        pw3.x = pk_bf16(s1[8], s1[9]); pw3.y = pk_bf16(s1[10], s1[11]); pw3.z = pk_bf16(s1[12], s1[13]); pw3.w = pk_bf16(s1[14], s1[15]);
        AT_PV1(0, pw0, sb); AT_PV1(1, pw1, sb); AT_PV1(2, pw2, sb); AT_PV1(3, pw3, sb);
        float mx; AT_ROWMAX(n0, n1, mx);
        if (t + 1 < NT && __any(mx > 8.0f)) {
            const float dl = __builtin_fmaxf(mx, 0.f), al = __builtin_amdgcn_exp2f(-dl); m_ref += dl; l_run *= al;
#pragma unroll
            for (int c = 0; c < C::NC; ++c)
#pragma unroll
                for (int r = 0; r < 16; ++r) o[c][r] *= al;
#pragma unroll
            for (int r = 0; r < 16; ++r) { n0[r] -= dl; n1[r] -= dl; negm[r] = -m_ref; }
        }
        s0 = n0; s1 = n1;
        AT_STORES(t + 2);
        AT_LOADS(t + 3);
        __syncthreads();
    }
    __builtin_amdgcn_s_setprio(0);
#undef AT_LOADS
#undef AT_STORES
#undef AT_PV1
#undef AT_QK
#undef AT_ROWMAX
#undef MX3
    l_run = xhalf_sum(l_run);
    const float inv = 1.0f / l_run;
    if (MODE == 1) {
        LAS f32x4* xch = (LAS f32x4*)(lds + XCH_OFF) + (size_t)(wid & 3) * 16 * 64 + lane;
        f32x4 ggv[C::NC][4];
        if (wid < 4) {
#pragma unroll
            for (int c = 0; c < C::NC; ++c)
#pragma unroll
                for (int g = 0; g < 4; ++g) ggv[c][g] = *(const f32x4*)(subg + 32 * c + 8 * g + 4 * hi);
        }
        __builtin_amdgcn_sched_barrier(0);
        if (wid >= 4) {
#pragma unroll
            for (int c = 0; c < C::NC; ++c)
#pragma unroll
                for (int g = 0; g < 4; ++g) xch[(c * 4 + g) * 64] = (f32x4){o[c][4 * g] * inv, o[c][4 * g + 1] * inv, o[c][4 * g + 2] * inv, o[c][4 * g + 3] * inv};
        }
        __syncthreads();
        if (wid < 4) {
            float ss = 0.f;
#pragma unroll
            for (int c = 0; c < C::NC; ++c)
#pragma unroll
                for (int g = 0; g < 4; ++g) { const f32x4 x = xch[(c * 4 + g) * 64];
#pragma unroll
                    for (int j = 0; j < 4; ++j) { const float v = o[c][4 * g + j] * inv - lam * x[j]; o[c][4 * g + j] = v; ss += v * v; } }
            ss = xhalf_sum(ss);
            const float rn = 0.8f / sqrtf(ss * (1.0f / 128.0f) + EPS);
#pragma unroll
            for (int c = 0; c < C::NC; ++c)
#pragma unroll
                for (int gp = 0; gp < 2; ++gp) { u32x2 w[2];
#pragma unroll
                    for (int q = 0; q < 2; ++q) { const int g = 2 * gp + q; const f32x4 gg = ggv[c][g];
                        w[q].x = pk_bf16(o[c][4 * g] * rn * gg[0], o[c][4 * g + 1] * rn * gg[1]); w[q].y = pk_bf16(o[c][4 * g + 2] * rn * gg[2], o[c][4 * g + 3] * rn * gg[3]); }
                    *(u32x4*)(Op + (size_t)r32 * ldo + 32 * c + 16 * gp + 8 * hi) = widen_pair(w[0], w[1]); }
        }
    } else {
#pragma unroll
        for (int c = 0; c < C::NC; ++c)
#pragma unroll
            for (int gp = 0; gp < 2; ++gp) { u32x2 w[2];
#pragma unroll
                for (int q = 0; q < 2; ++q) { const int g = 2 * gp + q;
                    w[q].x = pk_bf16(o[c][4 * g] * inv, o[c][4 * g + 1] * inv); w[q].y = pk_bf16(o[c][4 * g + 2] * inv, o[c][4 * g + 3] * inv); }
                *(u32x4*)(Op + (size_t)r32 * ldo + 32 * c + 16 * gp + 8 * hi) = widen_pair(w[0], w[1]); }
    }
}

__device__ __forceinline__ void p0_transpose_item(const float* W, int K, int N, bf16_t* WT, LAS float* scr, int item, int lane, const float* gvec, int pmode) {
    const int nblk = N / 32, kb = item / nblk, nb = item % nblk, k0 = 64 * kb, n0 = 32 * nb;
    float v[32];
#pragma unroll
    for (int i = 0; i < 32; ++i) v[i] = W[(size_t)(k0 + 2 * i + (lane >> 5)) * N + n0 + (lane & 31)];
    if (gvec) {
#pragma unroll
        for (int i = 0; i < 32; ++i) v[i] *= gvec[k0 + 2 * i + (lane >> 5)];
    }
#pragma unroll
    for (int i = 0; i < 32; ++i) scr[(2 * i + (lane >> 5)) * 33 + (lane & 31)] = v[i];
    asm volatile("s_waitcnt lgkmcnt(0)" ::: "memory");
    int r0 = n0;
    if (pmode == 1) { const int U = n0 >> 6, hf = (n0 >> 5) & 1; r0 = 256 * (U >> 2) + 128 * hf + 32 * (U & 3); }
    else if (pmode == 2) { const int hf = n0 / DFF, f = n0 - hf * DFF; r0 = 256 * (f >> 7) + 128 * hf + (f & 127); }
    const int c = lane & 7;
#pragma unroll
    for (int j = 0; j < 4; ++j) { const int n = (lane >> 3) + 8 * j; const LAS float* s = scr + (8 * c) * 33 + n;
        u32x4 o; o.x = pk_bf16(s[0 * 33], s[1 * 33]); o.y = pk_bf16(s[2 * 33], s[3 * 33]); o.z = pk_bf16(s[4 * 33], s[5 * 33]); o.w = pk_bf16(s[6 * 33], s[7 * 33]);
        *(u32x4*)(WT + (size_t)(r0 + n) * K + k0 + 8 * c) = o; }
    asm volatile("s_waitcnt lgkmcnt(0)" ::: "memory");
}
__device__ __forceinline__ void row_to_bf16(const float* xrow, bf16_t* orow, float* rstd, int lane) {
    const f32x4* xr = (const f32x4*)xrow + lane;
    f32x4 v[4]; float s = 0.f;
#pragma unroll
    for (int j = 0; j < 4; ++j) { v[j] = xr[64 * j]; s += (v[j].x * v[j].x + v[j].y * v[j].y) + (v[j].z * v[j].z + v[j].w * v[j].w); }
    s = wave_sum(s);
    if (lane == 0) *rstd = 1.0f / sqrtf(s * (1.0f / 1024.0f) + EPS);
    u32x2* o8 = (u32x2*)orow + lane;
#pragma unroll
    for (int j = 0; j < 4; ++j) { u32x2 w; w.x = pk_bf16(v[j].x, v[j].y); w.y = pk_bf16(v[j].z, v[j].w); o8[64 * j] = w; }
}

#ifndef REP0
#define REP0 1
#endif
#ifndef NSYNC_EXTRA
#define NSYNC_EXTRA 0
#endif
#ifndef PROBE_GQA2
#define PROBE_GQA2 0
#endif
#ifndef REP1
#define REP1 1
#endif
#ifndef REP2
#define REP2 1
#endif
#ifndef REP4
#define REP4 1
#endif
#ifndef REP5
#define REP5 1
#endif
#ifndef REP7
#define REP7 1
#endif

#define XB_TMO      128
#define XB_XCNT(j)  (256  + 64 * (j))
#define XB_XSUB(j)  (1280 + 64 * (j))
#define XB_XGEN(j)  (2304 + 64 * (j))
#define XB_TOP      3328
#define XB_TOPGEN   3392
#define XCD_BAR_WORDS 3456
#define XB_SPIN_CAP (1u << 22)
__device__ __forceinline__ unsigned xb_ld(unsigned* p)              { return __hip_atomic_load(p, __ATOMIC_RELAXED, __HIP_MEMORY_SCOPE_AGENT); }
__device__ __forceinline__ unsigned xb_add(unsigned* p, unsigned v) { return __hip_atomic_fetch_add(p, v, __ATOMIC_RELAXED, __HIP_MEMORY_SCOPE_AGENT); }
__device__ __forceinline__ unsigned xb_xcc_id() { return (unsigned)__builtin_amdgcn_s_getreg((3 << 11) | 20) & 0xFu; }
#define XB_SPIN(cond, bar) do { unsigned _sp = 0; while (cond) { __builtin_amdgcn_s_sleep(1); \
    if ((++_sp & 255u) == 0u) { if (xb_ld(&(bar)[XB_TMO])) break; if (_sp > XB_SPIN_CAP) { atomicAdd(&(bar)[XB_TMO], 1u); break; } } } } while (0)
struct XcdBarrier { unsigned* bar; unsigned x; volatile LAS unsigned* st; };
__device__ __forceinline__ XcdBarrier xcd_barrier_post(unsigned* bar, volatile LAS unsigned* st) {
    XcdBarrier b; b.bar = bar; b.x = xb_xcc_id(); b.st = st;
    if (threadIdx.x == 0) (void)xb_add(&bar[XB_XCNT(b.x)], 1u);
    return b;
}
__device__ __forceinline__ void xcd_barrier_complete(unsigned* bar, unsigned x, unsigned& nloc, unsigned& nx) {
    const unsigned G = gridDim.x * gridDim.y * gridDim.z;
    unsigned sum, cnt, mine, sp = 0u;
    for (;;) {
        sum = 0u; cnt = 0u; mine = 0u;
#pragma unroll
        for (unsigned j = 0; j < 16; ++j) { const unsigned c = xb_ld(&bar[XB_XCNT(j)]); sum += c; cnt += (c > 0u) ? 1u : 0u; mine = (j == x) ? c : mine; }
        if (sum == G) break;
        __builtin_amdgcn_s_sleep(1);
        if ((++sp & 255u) == 0u) { if (xb_ld(&bar[XB_TMO])) break; if (sp > XB_SPIN_CAP) { atomicAdd(&bar[XB_TMO], 1u); break; } }
    }
    nloc = mine > 0u ? mine : 1u; nx = cnt > 0u ? cnt : 1u;
}
__device__ __forceinline__ void xcd_barrier(const XcdBarrier& b) {
    asm volatile("s_waitcnt vmcnt(0)" ::: "memory");
    __syncthreads();
    if (threadIdx.x == 0) {
        unsigned* bar = b.bar;
        __builtin_amdgcn_s_waitcnt(0);
        unsigned nloc = b.st[0], nx = b.st[1];
        if (nloc == 0u) { xcd_barrier_complete(bar, b.x, nloc, nx); b.st[0] = nloc; b.st[1] = nx; }
        const unsigned old = xb_add(&bar[XB_XSUB(b.x)], 1u);
        const unsigned gen = old / nloc;
        if (old + 1u == (gen + 1u) * nloc) {
            __builtin_amdgcn_fence(__ATOMIC_RELEASE, "agent");
            asm volatile("s_waitcnt vmcnt(0)" ::: "memory");
            const unsigned og = xb_add(&bar[XB_TOP], 1u);
            const unsigned tg = og / nx;
            if (og + 1u == (tg + 1u) * nx) xb_add(&bar[XB_TOPGEN], 1u);
            else XB_SPIN(xb_ld(&bar[XB_TOPGEN]) == tg, bar);
            __builtin_amdgcn_fence(__ATOMIC_ACQUIRE, "agent");
            xb_add(&bar[XB_XGEN(b.x)], 1u);
            asm volatile("s_waitcnt vmcnt(0)" ::: "memory");
        } else {
            XB_SPIN(xb_ld(&bar[XB_XGEN(b.x)]) == gen, bar);
            __builtin_amdgcn_fence(__ATOMIC_ACQUIRE, "agent");
            asm volatile("s_waitcnt vmcnt(0)" ::: "memory");
        }
    }
    __syncthreads();
}

struct Args { const float* in[25]; float* out; unsigned char* ws; int ph_lo, ph_hi; };
constexpr int LDS_BYTES = 131072 + 1024 + 16384;

__global__ void __launch_bounds__(512, 2) fwd_mega(Args a) {
    __builtin_assume(__builtin_amdgcn_workitem_id_y() == 0); __builtin_assume(__builtin_amdgcn_workitem_id_z() == 0);
    extern __shared__ __attribute__((aligned(16))) unsigned char lds_raw[];
    LAS unsigned char* lds = (LAS unsigned char*)lds_raw;
    cg::grid_group grid = cg::this_grid();
    const int tid = threadIdx.x, lane = tid & 63, wave = __builtin_amdgcn_readfirstlane(tid >> 6);
    const int G = gridDim.x, bx = blockIdx.x;
    const int vcu = (G % 8 == 0) ? (bx % 8) * (G / 8) + bx / 8 : bx;
    unsigned char* ws = a.ws;
    float* ssq1 = (float*)(ws + WS_SSQ); float* ssq2 = ssq1 + TT; float* ssq3 = ssq2 + TT;
    float* rstd0 = (float*)(ws + WS_RSTD0); float* rstdm = (float*)(ws + WS_RSTDM); float* ones = (float*)(ws + WS_ONES);
    f32x2* tabP = (f32x2*)(ws + WS_TABP); f32x2* tabA = (f32x2*)(ws + WS_TABA);
    bf16_t* Wi = (bf16_t*)(ws + WS_WIN); bf16_t* Wo = (bf16_t*)(ws + WS_WOUT); bf16_t* Wq = (bf16_t*)(ws + WS_WXQ); bf16_t* Wkv = (bf16_t*)(ws + WS_WXKV);
    bf16_t* Wxo = (bf16_t*)(ws + WS_WXO); bf16_t* Wu = (bf16_t*)(ws + WS_WUP); bf16_t* Wd = (bf16_t*)(ws + WS_WDOWN);
    bf16_t* MB = (bf16_t*)(ws + WS_MB); bf16_t* KV = (bf16_t*)(ws + WS_KV); bf16_t* VT = (bf16_t*)(ws + WS_KV + 10 * MiB);
    bf16_t* D1 = (bf16_t*)a.out + (size_t)TT * DM;
    bf16_t* D0 = (bf16_t*)a.out;
    bf16_t* R0 = (bf16_t*)(ws + WS_R0); bf16_t* R1 = (bf16_t*)(ws + WS_R1); bf16_t* RQ = (bf16_t*)(ws + WS_RQ); bf16_t* ACT = (bf16_t*)(ws + WS_ACT);
    volatile LAS unsigned* bst = (volatile LAS unsigned*)(lds + 131072 + 64);
    if (tid < 2) bst[tid] = 0u;
    __syncthreads();
    const XcdBarrier xbar = xcd_barrier_post((unsigned*)(ws + WS_BAR), bst);
    const int lo = a.ph_lo, hi_ = a.ph_hi;
#define IN(k) (lo <= (k) && (k) < hi_)
#define SEAM(k) do { if (IN(k) && IN((k) + 1)) xcd_barrier(xbar); } while (0)

    if (IN(0)) for (int rep0 = 0; rep0 < REP0; ++rep0) {
        const int gw = vcu * 8 + wave, NGW = G * 8, gtid = bx * 512 + tid, NTH = G * 512;
        for (int i = gtid; i < 3 * TT; i += NTH) ssq1[i] = 0.f;
        for (int i = gtid; i < TT; i += NTH) ones[i] = 1.0f;
        LAS float* scr = (LAS float*)(lds + wave * 16384);
        constexpr int I_IN = 16 * 72, I_SQ = 16 * 32, I_KV = 16 * 64, I_UP = 16 * 176, I_DN = 44 * 32;
        constexpr int NITEMS = I_IN + 3 * I_SQ + I_KV + I_UP + I_DN;
        for (int it = gw; it < NITEMS; it += NGW) {
            int r = it;
            if (r < I_IN) { p0_transpose_item(a.in[5], DM, NPROJ, Wi, scr, r, lane, a.in[4], 1); continue; } r -= I_IN;
            if (r < I_SQ) { p0_transpose_item(a.in[13], DM, DM, Wo, scr, r, lane, nullptr, 0); continue; } r -= I_SQ;
            if (r < I_SQ) { p0_transpose_item(a.in[16], DM, DM, Wq, scr, r, lane, a.in[14], 0); continue; } r -= I_SQ;
            if (r < I_KV) { p0_transpose_item(a.in[17], DM, 2 * DM, Wkv, scr, r, lane, a.in[15], 0); continue; } r -= I_KV;
            if (r < I_SQ) { p0_transpose_item(a.in[18], DM, DM, Wxo, scr, r, lane, nullptr, 0); continue; } r -= I_SQ;
            if (r < I_UP) { p0_transpose_item(a.in[20], DM, NUP, Wu, scr, r, lane, a.in[19], 2); continue; } r -= I_UP;
            p0_transpose_item(a.in[23], DFF, DM, Wd, scr, r, lane, nullptr, 0);
        }
        for (int m0 = gw; m0 < TT; m0 += 4 * NGW) {
            f32x4 v[4][4]; float sq[4];
#pragma unroll
            for (int q = 0; q < 4; ++q) { const int m = m0 + q * NGW; const int mc = (m < TT) ? m : gw;
                const f32x4* xr = (const f32x4*)((mc < TP) ? a.in[0] + (size_t)mc * DM : a.in[1] + (size_t)(mc - TP) * DM) + lane;
#pragma unroll
                for (int j = 0; j < 4; ++j) v[q][j] = xr[64 * j]; }
#pragma unroll
            for (int q = 0; q < 4; ++q) { float s_ = 0.f;
#pragma unroll
                for (int j = 0; j < 4; ++j) s_ += (v[q][j].x * v[q][j].x + v[q][j].y * v[q][j].y) + (v[q][j].z * v[q][j].z + v[q][j].w * v[q][j].w);
                sq[q] = wave_sum(s_); }
#pragma unroll
            for (int q = 0; q < 4; ++q) { const int m = m0 + q * NGW; if (m < TT) {
                if (lane == 0) rstd0[m] = 1.0f / sqrtf(sq[q] * (1.0f / 1024.0f) + EPS);
                u32x2* o8 = (u32x2*)(D1 + (size_t)m * DM) + lane;
#pragma unroll
                for (int j = 0; j < 4; ++j) { u32x2 w; w.x = pk_bf16(v[q][j].x, v[q][j].y); w.y = pk_bf16(v[q][j].z, v[q][j].w); o8[64 * j] = w; } } }
        }
        for (int m = gw; m < NMEM; m += NGW) { const float* xr = (m < 1024) ? a.in[2] + (size_t)m * DM : a.in[3] + (size_t)(m - 1024) * DM; row_to_bf16(xr, MB + (size_t)m * DM, rstdm + m, lane); }
        __syncthreads();
    }
    SEAM(0);
    for (int xs = 0; xs < NSYNC_EXTRA; ++xs) grid.sync();

    if (IN(1)) for (int rep = 0; rep < REP1; ++rep) {
        { pg8::Gemm g{D1, Wi, DM, (size_t)256 * DM * 2, (size_t)128 * DM * 2}; pg8::StaticOrder S; S.init(TT / 256, NPROJ / 256, G, bx);
          pg8::EpiInProj E{RQ, rstd0, tabP, tabA, a.in[11], a.in[12]};
          pg8::gemm_phase<pg8::EpiInProj, false>(lds, g, S, E); }
        { pg8::Gemm g{MB, Wkv, DM, (size_t)256 * DM * 2, (size_t)128 * DM * 2}; pg8::StaticOrder S; S.init(NMEM / 256, DM / 256, G, (bx + 64) % G);
          pg8::EpiScaleBf16<false> E{KV, DM, rstdm, 1.0f};
          pg8::gemm_phase<pg8::EpiScaleBf16<false>, false>(lds, g, S, E); }
        { pg8::Gemm g{Wkv + (size_t)DM * DM, MB, DM, (size_t)256 * DM * 2, (size_t)128 * DM * 2}; pg8::StaticOrder S; S.init(DM / 256, NMEM / 256, G, (bx + 240) % G);
          pg8::EpiColScaleBf16 E{VT, NMEM, rstdm};
          pg8::gemm_phase<pg8::EpiColScaleBf16, false>(lds, g, S, E); }
    }
    SEAM(1);

    if (IN(2)) for (int rep = 0; rep < REP2; ++rep) {
        float lam;
        { const float s1 = wave_sum(a.in[6][lane] * a.in[7][lane]), s2 = wave_sum(a.in[8][lane] * a.in[9][lane]); lam = expf(s1) - expf(s2) + 0.2f; }
        for (int cls0 = 0; cls0 < 4 + PROBE_GQA2; ++cls0) { const int cls = (cls0 < 4) ? cls0 : cls0 - 2;
            const int n = (cls & 1) ? 1024 : 512, per = (n + G - 1) / G;
            const int i0 = vcu * per, i1 = (i0 + per < n) ? i0 + per : n;
            for (int id = i0; id < i1; ++id) {
                if (cls < 2) {
                    const int nqb = cls ? 16 : 32, S_ = cls ? 2048 : 4096;
                    const int qb = id % nqb, h = (id / nqb) & 3, seq = id / (nqb * 4);
                    const size_t row0 = (cls ? TP : 0) + (size_t)seq * S_, qrow = row0 + (size_t)qb * 128 + 32 * (wave & 3);
                    attn_unit<1>(lds, RQ + qrow * NPROJ + h * 128 + (wave >> 2) * 64, NPROJ, RQ + row0 * NPROJ + 512 + h * 128, NPROJ, RQ + row0 * NPROJ + 1024 + h * 128, NPROJ, S_ / 64,
                                 R0 + qrow * DM + h * 128, DM, lam, a.in[10]);
                } else {
                    const int nqb = (cls & 1) ? 8 : 16, S_ = (cls & 1) ? 2048 : 4096;
                    const int qb = id % nqb, h = (id / nqb) & 7, seq = id / (nqb * 8);
                    const size_t row0 = ((cls & 1) ? TP : 0) + (size_t)seq * S_, qrow = row0 + (size_t)qb * 256 + 32 * wave;
                    attn_unit<0>(lds, RQ + qrow * NPROJ + 1536 + h * 64, NPROJ, RQ + row0 * NPROJ + 2048 + (h >> 2) * 64, NPROJ, RQ + row0 * NPROJ + 2176 + (h >> 2) * 64, NPROJ, S_ / 64,
                                 R0 + qrow * DM + 512 + h * 64, DM, 0.f, nullptr);
                }
            }
        }
    }
    SEAM(2);

    if (IN(3)) {
        pg8::Gemm g{R0, Wo, DM, (size_t)256 * DM * 2, (size_t)128 * DM * 2}; pg8::StaticOrder S; S.init(TT / 256, DM / 256, G, bx);
        pg8::EpiResid<1> E{nullptr, nullptr, D1, D0, ssq1};
        pg8::gemm_phase<pg8::EpiResid<1>, false>(lds, g, S, E);
    }
    SEAM(3);

    if (IN(4)) for (int rep = 0; rep < REP4; ++rep) {
        pg8::Gemm g{D0, Wq, DM, (size_t)256 * DM * 2, (size_t)128 * DM * 2}; pg8::StaticOrder S; S.init(TT / 256, DM / 256, G, bx);
        pg8::EpiScaleBf16<true> E{R0, DM, ssq1, XSCALE};
        pg8::gemm_phase<pg8::EpiScaleBf16<true>, false>(lds, g, S, E);
    }
    SEAM(4);

    if (IN(5)) {
        { pg8::Gemm g{R0, KV, 256, 0, (size_t)128 * DM * 2, DM, DM}; pg8::StaticOrder S; S.init(TT / 256, 4, G, bx);
          pg8::EpiSoftmaxP E{R0, (LAS f32x2*)(lds + 131072 + 1024)};
          pg8::gemm_phase<pg8::EpiSoftmaxP, false, 1>(lds, g, S, E); }
        xcd_barrier(xbar);
        { pg8::Gemm g{R0, VT, 256, 0, (size_t)128 * DM * 2, DM, NMEM}; pg8::StaticOrder S; S.init(TT / 256, 4, G, bx);
          pg8::EpiScaleBf16<false> E{R1, DM, ones, 1.0f};
          pg8::gemm_phase<pg8::EpiScaleBf16<false>, false, 2>(lds, g, S, E); }
    }
    SEAM(5);

    if (IN(6)) {
        pg8::Gemm g{R1, Wxo, DM, (size_t)256 * DM * 2, (size_t)128 * DM * 2}; pg8::StaticOrder S; S.init(TT / 256, DM / 256, G, bx);
        pg8::EpiResid<1> E{nullptr, nullptr, D0, R0, ssq2};
        pg8::gemm_phase<pg8::EpiResid<1>, false>(lds, g, S, E);
    }
    SEAM(6);

    if (IN(7)) for (int rep = 0; rep < REP7; ++rep) {
        pg8::Gemm g{R0 - DM, Wu, DM, (size_t)252 * DM * 2, (size_t)4 * DM * 2}; pg8::StaticOrder S; S.init((TT + 251) / 252, DFF / 128, G, bx);
        pg8::EpiConvGate E{ACT, ssq2, a.in[21], a.in[22]};
        pg8::gemm_phase<pg8::EpiConvGate, true>(lds, g, S, E);
    }
    SEAM(7);

    if (IN(8)) {
        pg8::Gemm g{ACT, Wd, DFF, (size_t)256 * DFF * 2, (size_t)128 * DFF * 2}; pg8::StaticOrder S; S.init(TT / 256, DM / 256, G, bx);
        pg8::EpiResid<1> E{nullptr, nullptr, R0, R0, ssq3};
        pg8::gemm_phase<pg8::EpiResid<1>, false>(lds, g, S, E);
    }
    SEAM(8);

    if (IN(9)) {
        int t9 = threadIdx.x; asm volatile("" : "+v"(t9)); const int lane9 = t9 & 63;
        const int gw = vcu * 8 + wave, NGW = G * 8;
        const f32x4* gp = (const f32x4*)a.in[24] + lane9;
        f32x4 gv[4];
#pragma unroll
        for (int j = 0; j < 4; ++j) gv[j] = gp[64 * j];
        for (int m0 = gw; m0 < TT; m0 += 8 * NGW) {
            u32x2 v[8][4]; float rs[8];
#pragma unroll
            for (int q = 0; q < 8; ++q) { const int m = m0 + q * NGW; const int mc = (m < TT) ? m : gw;
                const u32x2* xr = (const u32x2*)(R0 + (size_t)mc * DM) + lane9; rs[q] = ssq3[mc];
#pragma unroll
                for (int j = 0; j < 4; ++j) v[q][j] = xr[64 * j]; }
#pragma unroll
            for (int q = 0; q < 8; ++q) { const int m = m0 + q * NGW; if (m < TT) {
                const float r_ = 1.0f / sqrtf(rs[q] * (1.0f / 1024.0f) + EPS);
                f32x4* xw = (f32x4*)(a.out + (size_t)m * DM) + lane9;
#pragma unroll
                for (int j = 0; j < 4; ++j) { const f32x4 x = {__uint_as_float(v[q][j].x << 16), __uint_as_float(v[q][j].x & 0xffff0000u), __uint_as_float(v[q][j].y << 16), __uint_as_float(v[q][j].y & 0xffff0000u)};
                    xw[64 * j] = x * r_ * gv[j]; } } }
        }
    }
    if (a.ph_hi > 1000) grid.sync();
#undef IN
#undef SEAM
}

extern "C" void kernel_launch(void* const* d_in, const int* in_sizes, int n_in, void* d_out, int out_size, void* d_ws, size_t ws_size, hipStream_t stream) {
    static int grid = 0;
    if (grid == 0) {
        if (n_in != 25 || out_size != TT * DM || ws_size < WS_END) { fprintf(stderr, "kernel_launch: unexpected shapes (n_in %d out %d ws %zu)\n", n_in, out_size, ws_size); grid = -1; return; }
        int dev = 0, cus = 0, per_cu = 0;
        hipGetDevice(&dev); hipDeviceGetAttribute(&cus, hipDeviceAttributeMultiprocessorCount, dev);
        hipFuncSetAttribute((const void*)fwd_mega, hipFuncAttributeMaxDynamicSharedMemorySize, LDS_BYTES);
        hipOccupancyMaxActiveBlocksPerMultiprocessor(&per_cu, (const void*)fwd_mega, 512, LDS_BYTES);
        if (per_cu < 1) { fprintf(stderr, "kernel_launch: occupancy query says %d blocks/CU\n", per_cu); per_cu = 1; }
        (void)hipGetLastError();
        grid = cus * per_cu;
    }
    if (grid < 0) return;
    if (hipMemsetAsync((char*)d_ws + WS_BAR, 0, BAR_BYTES, stream) != hipSuccess) { fprintf(stderr, "kernel_launch: memset of barrier words failed\n"); return; }
    Args a{};
    for (int i = 0; i < 25; ++i) a.in[i] = (const float*)d_in[i];
    a.out = (float*)d_out; a.ws = (unsigned char*)d_ws; a.ph_lo = 0; a.ph_hi = 10;
    void* args[] = {&a};
    hipError_t e = hipLaunchCooperativeKernel((const void*)fwd_mega, dim3(grid), dim3(512), args, LDS_BYTES, stream);
    if (e != hipSuccess) fprintf(stderr, "cooperative launch failed: %s (grid %d)\n", hipGetErrorString(e), grid);
}
```
